# Optimizing an MI355X kernel written in HIP

```python
import jax, jax.numpy as jnp
from jax import lax
import numpy as np

D_MODEL = 4096
BATCH = 1
SEQ = 8192
DEPTH = 1

CHUNK = 64
Q_BLOCK = 128
PLE_DIM = 256
EPS = 1e-6

POOL_WINDOWS = (2, 4, 8, 16)
POOL_GROUPS = len(POOL_WINDOWS)
POOL_WIDTH = D_MODEL // 2
POOL_GROUP_WIDTH = POOL_WIDTH // POOL_GROUPS

N_HEADS = 16
QK_NOPE_DIM = 128
QK_ROPE_DIM = 64
QK_DIM = QK_NOPE_DIM + QK_ROPE_DIM
V_HEAD_DIM = 128
MLA_WIDTH = N_HEADS * V_HEAD_DIM
Q_LORA_RANK = D_MODEL // 4
KV_LORA_RANK = 512
ROPE_THETA = 10000.0

IN_WIDTH = POOL_WIDTH + Q_LORA_RANK + KV_LORA_RANK + QK_ROPE_DIM
N_BRANCHES = 2

D_FF = -(-8 * D_MODEL // (3 * 256)) * 256

kernel_name = "hybrid_pool_mla_gated_encoder"


def rms_norm(x, g):
    xf = x.astype(jnp.float32)
    xf = xf * lax.rsqrt(jnp.mean(xf * xf, axis=-1, keepdims=True) + EPS)
    return (xf * g.astype(jnp.float32)).astype(x.dtype)


def rope_tables(positions):
    inv_freq = ROPE_THETA ** (-jnp.arange(0, QK_ROPE_DIM, 2, dtype=jnp.float32) / QK_ROPE_DIM)
    ang = positions.astype(jnp.float32)[..., None] * inv_freq
    return jnp.cos(ang), jnp.sin(ang)


def apply_rope(x, cos, sin):
    xf = x.astype(jnp.float32)
    x1, x2 = xf[..., :QK_ROPE_DIM // 2], xf[..., QK_ROPE_DIM // 2:]
    out = jnp.concatenate([x1 * cos - x2 * sin, x1 * sin + x2 * cos], axis=-1)
    return out.astype(x.dtype)


def pool_mixer(u, w_pool, pool_scale):
    b, s, _ = u.shape
    uf = u.astype(jnp.float32).reshape(b, s, POOL_GROUPS, POOL_GROUP_WIDTH)
    cs = jnp.pad(jnp.cumsum(uf, axis=1), ((0, 0), (1, 0), (0, 0), (0, 0)))
    t = jnp.arange(s)
    outs = []
    for g, w in enumerate(POOL_WINDOWS):
        start = jnp.maximum(t + 1 - w, 0)
        cnt = (t + 1 - start).astype(jnp.float32)[None, :, None]
        win_sum = cs[:, 1:, g] - cs[:, start, g]
        outs.append(win_sum / cnt - uf[:, :, g])
    pooled = jnp.stack(outs, axis=2).astype(u.dtype)
    mixed = jnp.einsum('bsgc,gcd->bsgd', pooled, w_pool)
    return mixed.reshape(b, s, POOL_WIDTH) * pool_scale


def mla_mixer(q_lat, kv_lat, k_rope, cos, sin, q_norm, kv_norm, w_q_b, w_kv_b):
    b, s, _ = q_lat.shape
    q = jnp.einsum('bsr,rhd->bshd', rms_norm(q_lat, q_norm), w_q_b)
    q_nope = q[..., :QK_NOPE_DIM]
    q_rope = apply_rope(q[..., QK_NOPE_DIM:], cos[:, :, None], sin[:, :, None])
    kv = jnp.einsum('bsr,rhd->bshd', rms_norm(kv_lat, kv_norm), w_kv_b)
    k_nope, v = kv[..., :QK_NOPE_DIM], kv[..., QK_NOPE_DIM:]
    k_rope = apply_rope(k_rope, cos, sin)
    scale = QK_DIM ** -0.5
    n_blocks = s // Q_BLOCK

    def to_blocks(a):
        return a.reshape(b, n_blocks, Q_BLOCK, *a.shape[2:]).swapaxes(0, 1)

    key_chunk = jnp.arange(s) // CHUNK
    q_starts = jnp.arange(n_blocks) * Q_BLOCK

    def attend(args):
        qn, qr, start = args
        sc = (jnp.einsum('bqhd,bkhd->bhqk', qn, k_nope, preferred_element_type=jnp.float32)
              + jnp.einsum('bqhd,bkd->bhqk', qr, k_rope, preferred_element_type=jnp.float32)) * scale
        q_chunk = (start + jnp.arange(Q_BLOCK)) // CHUNK
        mask = key_chunk[None, :] <= q_chunk[:, None]
        sc = jnp.where(mask[None, None], sc, -jnp.inf)
        pr = jax.nn.softmax(sc, axis=-1).astype(v.dtype)
        return jnp.einsum('bhqk,bkhd->bqhd', pr, v)

    out = lax.map(attend, (to_blocks(q_nope), to_blocks(q_rope), q_starts))
    return out.swapaxes(0, 1).reshape(b, s, MLA_WIDTH)


def setup_inputs(seed: int = 0) -> dict:
    key = jax.random.key(seed)
    ks = jax.random.split(key, 32)
    f32 = jnp.float32

    def dense(k, shape, fan_in):
        return jax.random.normal(k, shape, f32) * (fan_in ** -0.5)

    def gain(k, dim):
        return 1.0 + 0.1 * jax.random.normal(k, (DEPTH, dim), f32)

    offset = jax.random.randint(ks[2], (BATCH, 1), 0, 1024, dtype=jnp.int32)
    positions = offset + jnp.arange(SEQ, dtype=jnp.int32)[None, :]
    return {
        "x": jax.random.normal(ks[0], (BATCH, SEQ, D_MODEL), f32),
        "p": jax.random.normal(ks[1], (DEPTH, BATCH, SEQ, PLE_DIM), f32),
        "positions": positions,
        "norm_mix_pre": gain(ks[3], D_MODEL),
        "norm_mix_post": gain(ks[4], D_MODEL),
        "w_in": dense(ks[5], (DEPTH, D_MODEL, IN_WIDTH), D_MODEL),
        "q_norm": gain(ks[6], Q_LORA_RANK),
        "kv_norm": gain(ks[7], KV_LORA_RANK),
        "w_q_b": dense(ks[8], (DEPTH, Q_LORA_RANK, N_HEADS, QK_DIM), Q_LORA_RANK),
        "w_kv_b": dense(ks[9], (DEPTH, KV_LORA_RANK, N_HEADS, QK_NOPE_DIM + V_HEAD_DIM), KV_LORA_RANK),
        "w_pool": dense(ks[10], (DEPTH, POOL_GROUPS, POOL_GROUP_WIDTH, POOL_GROUP_WIDTH), POOL_GROUP_WIDTH),
        "pool_scale": gain(ks[11], POOL_WIDTH),
        "w_up_pool": dense(ks[12], (DEPTH, POOL_WIDTH, D_MODEL), POOL_WIDTH),
        "w_up_mla": dense(ks[13], (DEPTH, MLA_WIDTH, D_MODEL), MLA_WIDTH),
        "w_branch_gate": dense(ks[14], (DEPTH, D_MODEL, N_BRANCHES, D_MODEL), D_MODEL),
        "w_out": dense(ks[15], (DEPTH, D_MODEL, D_MODEL), D_MODEL),
        "norm_ffn_pre": gain(ks[16], D_MODEL),
        "norm_ffn_post": gain(ks[17], D_MODEL),
        "w_ffn_gate": dense(ks[18], (DEPTH, D_MODEL, D_FF), D_MODEL),
        "w_ffn_up": dense(ks[19], (DEPTH, D_MODEL, D_FF), D_MODEL),
        "w_ffn_down": dense(ks[20], (DEPTH, D_FF, D_MODEL), D_FF),
        "norm_ple_pre": gain(ks[21], D_MODEL),
        "w_ple_gate": dense(ks[22], (DEPTH, D_MODEL, D_MODEL), D_MODEL),
        "w_ple_proj": dense(ks[23], (DEPTH, PLE_DIM, D_MODEL), PLE_DIM),
        "norm_ple_post": gain(ks[24], D_MODEL),
    }


def reference(x, p, positions, norm_mix_pre, norm_mix_post, w_in, q_norm, kv_norm, w_q_b, w_kv_b,
              w_pool, pool_scale, w_up_pool, w_up_mla, w_branch_gate, w_out, norm_ffn_pre,
              norm_ffn_post, w_ffn_gate, w_ffn_up, w_ffn_down, norm_ple_pre, w_ple_gate,
              w_ple_proj, norm_ple_post):
    cos, sin = rope_tables(positions)
    o1 = POOL_WIDTH
    o2 = o1 + Q_LORA_RANK
    o3 = o2 + KV_LORA_RANK
    for i in range(DEPTH):
        h = rms_norm(x, norm_mix_pre[i])
        z = jnp.einsum('bsd,de->bse', h, w_in[i])
        u_pool, q_lat, kv_lat, k_rope = z[..., :o1], z[..., o1:o2], z[..., o2:o3], z[..., o3:]
        ya = jnp.einsum('bsc,cd->bsd', pool_mixer(u_pool, w_pool[i], pool_scale[i]), w_up_pool[i])
        yb = jnp.einsum('bsc,cd->bsd',
                        mla_mixer(q_lat, kv_lat, k_rope, cos, sin, q_norm[i], kv_norm[i],
                                  w_q_b[i], w_kv_b[i]),
                        w_up_mla[i])
        gates = jax.nn.sigmoid(jnp.einsum('bsd,dge->bsge', h, w_branch_gate[i]))
        merged = gates[:, :, 0] * ya + gates[:, :, 1] * yb
        mix = jnp.einsum('bsd,de->bse', merged, w_out[i])
        x = x + rms_norm(mix, norm_mix_post[i])
        h2 = rms_norm(x, norm_ffn_pre[i])
        act = jax.nn.silu(jnp.einsum('bsd,df->bsf', h2, w_ffn_gate[i])) * jnp.einsum('bsd,df->bsf', h2, w_ffn_up[i])
        ffn = jnp.einsum('bsf,fd->bsd', act, w_ffn_down[i])
        x = x + rms_norm(ffn, norm_ffn_post[i])
        gate = jax.nn.sigmoid(jnp.einsum('bsd,de->bse', rms_norm(x, norm_ple_pre[i]), w_ple_gate[i]))
        pe = jnp.einsum('bsr,rd->bsd', p[i].astype(x.dtype), w_ple_proj[i])
        x = x + rms_norm(pe * gate, norm_ple_post[i])
    return x
```

```cpp
#include <hip/hip_runtime.h>
#include <cstdio>
#include <cstdint>

namespace pg8 {
#define PG8_LAS __attribute__((address_space(3)))
typedef unsigned short bf16_t;
typedef short bf16x8 __attribute__((ext_vector_type(8)));
typedef float f32x4 __attribute__((ext_vector_type(4)));
typedef unsigned u32x4 __attribute__((ext_vector_type(4)));
typedef unsigned u32x2 __attribute__((ext_vector_type(2)));
constexpr int BM = 256, BK = 64, HALF = 128, HTB = HALF * BK * 2  , STAGE_BYTES = 8 * HTB, NXCD = 8, WGM = 8;

__host__ __device__ __forceinline__ int lds_byte(int r, int c) { const int st = (r >> 4) * 2 + (c >> 5), rr = r & 15, cc = c & 31, ob = rr * 64 + cc * 2; return st * 1024 + (ob ^ (((ob >> 9) & 1) << 5)); }
__host__ __device__ __forceinline__ void stage_rc(int b, int& R, int& C) { const int st = b / 1024, sb = b % 1024, swz = sb ^ (((sb >> 9) & 1) << 5); R = (st >> 1) * 16 + swz / 64; C = (st & 1) * 32 + (swz % 64) / 2; }
__host__ __device__ __forceinline__ int perm32(int rho) { const int n = rho >> 4, i = rho & 15; return 8 * (i >> 2) + 4 * n + (i & 3); }

struct Unit { int pm, pn; };
struct Gemm { const bf16_t* A; const bf16_t* Bt; int M, N, K, lda, ldb; };

struct StaticOrder {
    int nM, nN, nwg, G, c;
    __host__ __device__ void init(int M, int N, int G_, int c_) { nM = M / BM; nN = N / BM; nwg = nM * nN; G = G_; c = c_; }
    __host__ __device__ bool next(int i, Unit& u) const {
        const long L = (long)i * G + c; if (L >= nwg) return false;
        int wgid = (int)L; { const int q = nwg / NXCD, r = nwg % NXCD, xcd = wgid % NXCD, off = wgid / NXCD; wgid = (xcd < r ? xcd * (q + 1) : r * (q + 1) + (xcd - r) * q) + off; }
        const int nig = WGM * nN, gid = wgid / nig, fm = gid * WGM, gsz = (nM - fm) < WGM ? (nM - fm) : WGM;
        u.pm = fm + ((wgid % nig) % gsz); u.pn = (wgid % nig) / gsz; return true;
    }
    __device__ __forceinline__ void a_ready(const Unit&) const {}
    __device__ __forceinline__ void done(const Unit&) const {}
};

__device__ __forceinline__ unsigned cvt_pk_bf16(float lo, float hi) { unsigned r; asm volatile("v_cvt_pk_bf16_f32 %0, %1, %2" : "=v"(r) : "v"(lo), "v"(hi)); return r; }
__device__ __forceinline__ float bf_lo(unsigned w) { return __uint_as_float(w << 16); }
__device__ __forceinline__ float bf_hi(unsigned w) { return __uint_as_float(w & 0xffff0000u); }
__device__ __forceinline__ float sigm(float v) { return __builtin_amdgcn_rcpf(1.0f + __builtin_amdgcn_exp2f(-1.4426950408889634f * v)); }
__device__ __forceinline__ f32x4 sigm4(f32x4 v) { return (f32x4){sigm(v[0]), sigm(v[1]), sigm(v[2]), sigm(v[3])}; }
__device__ __forceinline__ u32x4 pack8(f32x4 v0, f32x4 v1) { u32x4 w; w.x = cvt_pk_bf16(v0[0], v0[1]); w.y = cvt_pk_bf16(v0[2], v0[3]); w.z = cvt_pk_bf16(v1[0], v1[1]); w.w = cvt_pk_bf16(v1[2], v1[3]); return w; }

struct EpiF32 {
    static constexpr bool PERM = false, AFTER_DRAIN = false;
    float* C; int ldc;
    __device__ __forceinline__ void operator()(const f32x4 (&acc)[2][2][4][2], const Unit& u, int wr, int wc, int fr, int fq) const {
        const int row0 = u.pm * BM + wr * 64 + fr, col0 = u.pn * BM + wc * 32 + 4 * fq;
#pragma unroll
        for (int ai = 0; ai < 2; ++ai)
#pragma unroll
            for (int m = 0; m < 4; ++m) { float* rowp = C + (size_t)(row0 + ai * HALF + m * 16) * ldc + col0;
#pragma unroll
                for (int bj = 0; bj < 2; ++bj)
#pragma unroll
                    for (int n = 0; n < 2; ++n) *(f32x4*)(rowp + bj * HALF + n * 16) = acc[ai][bj][m][n]; }
    }
};
struct EpiZG {
    static constexpr bool PERM = true, AFTER_DRAIN = false;
    bf16_t* Z; bf16_t* G;
    __device__ __forceinline__ void operator()(const f32x4 (&acc)[2][2][4][2], const Unit& u, int wr, int wc, int fr, int fq) const {
        const int row0 = u.pm * BM + wr * 64 + fr; const bool isg = u.pn >= 15;
        const int ldc = isg ? 8192 : 3840; bf16_t* base = isg ? G : Z; const int col0 = (isg ? (u.pn - 15) : u.pn) * BM + wc * 32 + 8 * fq;
#pragma unroll
        for (int ai = 0; ai < 2; ++ai)
#pragma unroll
            for (int m = 0; m < 4; ++m) { bf16_t* rowp = base + (size_t)(row0 + ai * HALF + m * 16) * ldc + col0;
#pragma unroll
                for (int bj = 0; bj < 2; ++bj) { f32x4 v0 = acc[ai][bj][m][0], v1 = acc[ai][bj][m][1];
                    if (isg) { v0 = sigm4(v0); v1 = sigm4(v1); }
                    *(u32x4*)(rowp + bj * HALF) = pack8(v0, v1); } }
    }
};
struct EpiBf16Scale {
    static constexpr bool PERM = true, AFTER_DRAIN = false;
    bf16_t* O; int ldc; const float* colscale; const float* rowscale;
    __device__ __forceinline__ void operator()(const f32x4 (&acc)[2][2][4][2], const Unit& u, int wr, int wc, int fr, int fq) const {
        const int row0 = u.pm * BM + wr * 64 + fr, col0 = u.pn * BM + wc * 32 + 8 * fq;
        f32x4 cs[2][2];
#pragma unroll
        for (int bj = 0; bj < 2; ++bj)
#pragma unroll
            for (int n = 0; n < 2; ++n) cs[bj][n] = colscale ? *(const f32x4*)(colscale + col0 + bj * HALF + 4 * n) : (f32x4){1.f, 1.f, 1.f, 1.f};
#pragma unroll
        for (int ai = 0; ai < 2; ++ai)
#pragma unroll
            for (int m = 0; m < 4; ++m) { const int r = row0 + ai * HALF + m * 16; const float rs = rowscale ? rowscale[r] : 1.f; bf16_t* rowp = O + (size_t)r * ldc + col0;
#pragma unroll
                for (int bj = 0; bj < 2; ++bj) { const f32x4 v0 = acc[ai][bj][m][0] * cs[bj][0] * rs, v1 = acc[ai][bj][m][1] * cs[bj][1] * rs;
                    *(u32x4*)(rowp + bj * HALF) = pack8(v0, v1); } }
    }
};
struct EpiQ {
    static constexpr bool PERM = true, AFTER_DRAIN = false;
    bf16_t* O; const float* rstd; const float* cosT; const float* sinT;
    __device__ __forceinline__ void operator()(const f32x4 (&acc)[2][2][4][2], const Unit& u, int wr, int wc, int fr, int fq) const {
        const int row0 = u.pm * BM + wr * 64 + fr, col0 = u.pn * BM + wc * 32 + 8 * fq;
        bool rope[2]; int i0[2];
#pragma unroll
        for (int bj = 0; bj < 2; ++bj) { const int c = col0 + bj * HALF, dd = c % 192; rope[bj] = dd >= 128; i0[bj] = rope[bj] ? (dd - 128) >> 1 : 0; }
#pragma unroll
        for (int ai = 0; ai < 2; ++ai)
#pragma unroll
            for (int m = 0; m < 4; ++m) { const int r = row0 + ai * HALF + m * 16; const float rs = rstd[r]; bf16_t* rowp = O + (size_t)r * 3072 + col0;
#pragma unroll
                for (int bj = 0; bj < 2; ++bj) { f32x4 v0 = acc[ai][bj][m][0] * rs, v1 = acc[ai][bj][m][1] * rs;
                    if (rope[bj]) { const f32x4 cs = *(const f32x4*)(cosT + (size_t)r * 32 + i0[bj]), sn = *(const f32x4*)(sinT + (size_t)r * 32 + i0[bj]);
                        const f32x4 a = v0, b = v1;
                        v0[0] = a[0] * cs[0] - a[1] * sn[0]; v0[1] = a[0] * sn[0] + a[1] * cs[0]; v0[2] = a[2] * cs[1] - a[3] * sn[1]; v0[3] = a[2] * sn[1] + a[3] * cs[1];
                        v1[0] = b[0] * cs[2] - b[1] * sn[2]; v1[1] = b[0] * sn[2] + b[1] * cs[2]; v1[2] = b[2] * cs[3] - b[3] * sn[3]; v1[3] = b[2] * sn[3] + b[3] * cs[3]; }
                    *(u32x4*)(rowp + bj * HALF) = pack8(v0, v1); } }
    }
};
struct EpiGateMulBf16 {
    static constexpr bool PERM = true, AFTER_DRAIN = false;
    bf16_t* T; const bf16_t* Gt;
    __device__ __forceinline__ void operator()(const f32x4 (&acc)[2][2][4][2], const Unit& u, int wr, int wc, int fr, int fq) const {
        const int row0 = u.pm * BM + wr * 64 + fr, col0 = u.pn * BM + wc * 32 + 8 * fq;
#pragma unroll
        for (int ai = 0; ai < 2; ++ai)
#pragma unroll
            for (int m = 0; m < 4; ++m) { const int r = row0 + ai * HALF + m * 16; bf16_t* rowp = T + (size_t)r * 4096 + col0; const bf16_t* gp = Gt + (size_t)r * 8192 + col0;
#pragma unroll
                for (int bj = 0; bj < 2; ++bj) { const u32x4 g = *(const u32x4*)(gp + bj * HALF);
                    const f32x4 g0 = {bf_lo(g.x), bf_hi(g.x), bf_lo(g.y), bf_hi(g.y)}, g1 = {bf_lo(g.z), bf_hi(g.z), bf_lo(g.w), bf_hi(g.w)};
                    *(u32x4*)(rowp + bj * HALF) = pack8(acc[ai][bj][m][0] * g0, acc[ai][bj][m][1] * g1); } }
    }
};
struct EpiGateAddBf16 {
    static constexpr bool PERM = true, AFTER_DRAIN = false;
    bf16_t* O; const bf16_t* T; const bf16_t* Gt;
    __device__ __forceinline__ void operator()(const f32x4 (&acc)[2][2][4][2], const Unit& u, int wr, int wc, int fr, int fq) const {
        const int row0 = u.pm * BM + wr * 64 + fr, col0 = u.pn * BM + wc * 32 + 8 * fq;
#pragma unroll
        for (int ai = 0; ai < 2; ++ai)
#pragma unroll
            for (int m = 0; m < 4; ++m) { const int r = row0 + ai * HALF + m * 16; const bf16_t* tp = T + (size_t)r * 4096 + col0; const bf16_t* gp = Gt + (size_t)r * 8192 + col0; bf16_t* rowp = O + (size_t)r * 4096 + col0;
#pragma unroll
                for (int bj = 0; bj < 2; ++bj) { const u32x4 g = *(const u32x4*)(gp + bj * HALF), t = *(const u32x4*)(tp + bj * HALF);
                    const f32x4 g0 = {bf_lo(g.x), bf_hi(g.x), bf_lo(g.y), bf_hi(g.y)}, g1 = {bf_lo(g.z), bf_hi(g.z), bf_lo(g.w), bf_hi(g.w)};
                    const f32x4 t0 = {bf_lo(t.x), bf_hi(t.x), bf_lo(t.y), bf_hi(t.y)}, t1 = {bf_lo(t.z), bf_hi(t.z), bf_lo(t.w), bf_hi(t.w)};
                    *(u32x4*)(rowp + bj * HALF) = pack8(t0 + acc[ai][bj][m][0] * g0, t1 + acc[ai][bj][m][1] * g1); } }
    }
};
struct EpiSwiGLU {
    static constexpr bool PERM = true, AFTER_DRAIN = false;
    bf16_t* O;
    __device__ __forceinline__ void operator()(const f32x4 (&acc)[2][2][4][2], const Unit& u, int wr, int wc, int fr, int fq) const {
        const int row0 = u.pm * BM + wr * 64 + fr, col0 = u.pn * 128 + wc * 16 + 4 * fq;
#pragma unroll
        for (int ai = 0; ai < 2; ++ai)
#pragma unroll
            for (int m = 0; m < 4; ++m) { bf16_t* rowp = O + (size_t)(row0 + ai * HALF + m * 16) * 11008 + col0;
#pragma unroll
                for (int bj = 0; bj < 2; ++bj) { const f32x4 gt = acc[ai][bj][m][0], up = acc[ai][bj][m][1]; const f32x4 a = gt * sigm4(gt) * up;
                    u32x2 w; w.x = cvt_pk_bf16(a[0], a[1]); w.y = cvt_pk_bf16(a[2], a[3]); *(u32x2*)(rowp + bj * 64) = w; } }
    }
};
struct EpiPle {
    static constexpr bool PERM = true, AFTER_DRAIN = false;
    bf16_t* T;
    __device__ __forceinline__ void operator()(const f32x4 (&acc)[2][2][4][2], const Unit& u, int wr, int wc, int fr, int fq) const {
        const int row0 = u.pm * BM + wr * 64 + fr, col0 = u.pn * BM + wc * 32 + 8 * fq;
#pragma unroll
        for (int ai = 0; ai < 2; ++ai)
#pragma unroll
            for (int m = 0; m < 4; ++m) { bf16_t* rowp = T + (size_t)(row0 + ai * HALF + m * 16) * 4096 + col0;
#pragma unroll
                for (int bj = 0; bj < 2; ++bj) { const u32x4 t = *(const u32x4*)(rowp + bj * HALF);
                    const f32x4 t0 = {bf_lo(t.x), bf_hi(t.x), bf_lo(t.y), bf_hi(t.y)}, t1 = {bf_lo(t.z), bf_hi(t.z), bf_lo(t.w), bf_hi(t.w)};
                    *(u32x4*)(rowp + bj * HALF) = pack8(t0 * sigm4(acc[ai][bj][m][0]), t1 * sigm4(acc[ai][bj][m][1])); }
                asm volatile("" ::: "memory"); }
    }
};

template <class Epi, class Sched, bool ALIGN_EPI = false, bool SP2 = false>
__device__ __forceinline__ void gemm_phase(PG8_LAS unsigned char* lds, const Gemm g, const Sched& S, const Epi& E) {
    int tz = threadIdx.x; asm volatile("" : "+v"(tz));
    const int tid = tz, wid = __builtin_amdgcn_readfirstlane(tid >> 6), lane = tid & 63, wr = wid >> 2, wc = wid & 3, fr = lane & 15, fq = lane >> 4;
    int Kl = g.K; asm volatile("" : "+s"(Kl));
    const int K = Kl, nt = K / BK;
    unsigned voffA[2], voffB[2];
#pragma unroll
    for (int i = 0; i < 2; ++i) { int R, C; stage_rc(tid * 16 + i * 8192, R, C); const int Rb = Epi::PERM ? ((R & ~31) + perm32(R & 31)) : R;
        voffA[i] = (unsigned)(R * g.lda + C) * 2u; voffB[i] = (unsigned)(Rb * g.ldb + C) * 2u; }
    const size_t kstep = (size_t)(BK * 2);
    const size_t hstepA = (size_t)HALF * g.lda * 2, hstepB = (size_t)HALF * g.ldb * 2;
    const size_t tstepA = 2 * hstepA, tstepB = 2 * hstepB;
    const unsigned ldsw = (unsigned)wid * 1024u;
    const int aoff = lds_byte(wr * 64 + fr, fq * 8), boff = lds_byte(wc * 32 + fr, fq * 8);
#define PG8_SA(b, h) (((b) * 2 + (h)) * HTB)
#define PG8_SB(b, h) ((4 + (b) * 2 + (h)) * HTB)
#define PG8_STAGE(bufoff, gbase, voff) do { _Pragma("unroll") for (int _i = 0; _i < 2; ++_i) \
        __builtin_amdgcn_global_load_lds((const unsigned*)((const char*)(gbase) + (voff)[_i]), (PG8_LAS unsigned*)(lds + (bufoff) + ldsw + _i * 8192), 16, 0, 0); } while (0)
#define PG8_LDA(dst, b, h) do { _Pragma("unroll") for (int m = 0; m < 4; ++m) _Pragma("unroll") for (int k = 0; k < 2; ++k) dst[m][k] = *(const PG8_LAS bf16x8*)(lds + PG8_SA(b, h) + aoff + m * 2048 + k * 1024); } while (0)
#define PG8_LDB(dst, b, h) do { _Pragma("unroll") for (int n = 0; n < 2; ++n) _Pragma("unroll") for (int k = 0; k < 2; ++k) dst[n][k] = *(const PG8_LAS bf16x8*)(lds + PG8_SB(b, h) + boff + n * 2048 + k * 1024); } while (0)
#define PG8_MMA(ai, bj, At, Bt) do { __builtin_amdgcn_s_setprio(1); _Pragma("unroll") for (int m = 0; m < 4; ++m) _Pragma("unroll") for (int n = 0; n < 2; ++n) _Pragma("unroll") for (int k = 0; k < 2; ++k) \
        acc[ai][bj][m][n] = __builtin_amdgcn_mfma_f32_16x16x32_bf16(Bt[n][k], At[m][k], acc[ai][bj][m][n], 0, 0, 0); __builtin_amdgcn_s_setprio(0); } while (0)
#define PG8_WAIT_V(n) asm volatile("s_waitcnt vmcnt(" #n ")" ::: "memory")
#define PG8_WAIT_L(n) asm volatile("s_waitcnt lgkmcnt(" #n ")" ::: "memory")
#define PG8_BAR __builtin_amdgcn_s_barrier()
#define PG8_SCHED __builtin_amdgcn_sched_barrier(0)
    Unit cur, nxt; int ui = 0;
    if (!S.next(0, cur)) return;
    f32x4 acc[2][2][4][2];
#pragma unroll
    for (int a = 0; a < 2; ++a)
#pragma unroll
        for (int b = 0; b < 2; ++b)
#pragma unroll
            for (int m = 0; m < 4; ++m)
#pragma unroll
                for (int n = 0; n < 2; ++n) acc[a][b][m][n] = (f32x4){0.f, 0.f, 0.f, 0.f};
    bf16x8 At[4][2], B0[2][2], B1[2][2];
    const char* cA = (const char*)g.A + (size_t)cur.pm * tstepA; const char* cB = (const char*)g.Bt + (size_t)cur.pn * tstepB;
    S.a_ready(cur);
    if constexpr (SP2) {
        PG8_STAGE(PG8_SB(0, 0), cB, voffB); PG8_STAGE(PG8_SB(0, 1), cB + hstepB, voffB); PG8_STAGE(PG8_SA(0, 0), cA, voffA); PG8_STAGE(PG8_SA(0, 1), cA + hstepA, voffA);
        if (wr == 1) PG8_BAR;
        PG8_WAIT_V(2); PG8_BAR;
        PG8_STAGE(PG8_SB(1, 0), cB + kstep, voffB); PG8_STAGE(PG8_SA(1, 0), cA + kstep, voffA); PG8_STAGE(PG8_SB(1, 1), cB + hstepB + kstep, voffB);
        PG8_WAIT_V(6); PG8_BAR;
    } else {
        PG8_STAGE(PG8_SB(0, 0), cB, voffB); PG8_STAGE(PG8_SA(0, 0), cA, voffA); PG8_STAGE(PG8_SB(0, 1), cB + hstepB, voffB); PG8_STAGE(PG8_SA(0, 1), cA + hstepA, voffA);
        if (wr == 1) PG8_BAR;
        PG8_WAIT_V(4); PG8_BAR;
        PG8_STAGE(PG8_SB(1, 0), cB + kstep, voffB); PG8_STAGE(PG8_SA(1, 0), cA + kstep, voffA); PG8_STAGE(PG8_SB(1, 1), cB + hstepB + kstep, voffB);
        PG8_WAIT_V(6); PG8_BAR;
    }
    for (;;) {
        const bool has_next = S.next(ui + 1, nxt);
        const char* nA = has_next ? (const char*)g.A + (size_t)nxt.pm * tstepA : cA; const char* nB = has_next ? (const char*)g.Bt + (size_t)nxt.pn * tstepB : cB;
        for (int t = 0; t < nt; t += 2) {
            const bool last = (t == nt - 2);
            const char* a1 = cA + (size_t)(t + 1) * kstep;
            const char* a2 = last ? nA : cA + (size_t)(t + 2) * kstep; const char* b2 = last ? nB : cB + (size_t)(t + 2) * kstep;
            const char* a3 = a2 + kstep; const char* b3 = b2 + kstep;
            if (last && has_next) S.a_ready(nxt);
            if constexpr (SP2) {
            PG8_LDB(B0, 0, 0); PG8_LDB(B1, 0, 1); PG8_SCHED; PG8_LDA(At, 0, 0); PG8_STAGE(PG8_SA(1, 1), a1 + hstepA, voffA);
            PG8_WAIT_V(8); PG8_WAIT_L(0); PG8_BAR; PG8_MMA(0, 0, At, B0); PG8_MMA(0, 1, At, B1); PG8_BAR; PG8_SCHED;
            PG8_LDA(At, 0, 1); PG8_STAGE(PG8_SB(0, 0), b2, voffB); PG8_STAGE(PG8_SB(0, 1), b2 + hstepB, voffB); PG8_STAGE(PG8_SA(0, 0), a2, voffA);
            PG8_WAIT_V(8); PG8_WAIT_L(0); PG8_BAR; PG8_MMA(1, 0, At, B0); PG8_MMA(1, 1, At, B1); PG8_BAR; PG8_SCHED;
            PG8_LDB(B0, 1, 0); PG8_LDB(B1, 1, 1); PG8_SCHED; PG8_LDA(At, 1, 0); PG8_STAGE(PG8_SA(0, 1), a2 + hstepA, voffA);
            PG8_WAIT_V(8); PG8_WAIT_L(0); PG8_BAR; PG8_MMA(0, 0, At, B0); PG8_MMA(0, 1, At, B1); PG8_BAR; PG8_SCHED;
            PG8_LDA(At, 1, 1); PG8_STAGE(PG8_SB(1, 0), b3, voffB); PG8_STAGE(PG8_SB(1, 1), b3 + hstepB, voffB); PG8_STAGE(PG8_SA(1, 0), a3, voffA);
            PG8_WAIT_V(8); PG8_WAIT_L(0); PG8_BAR; PG8_MMA(1, 0, At, B0); PG8_MMA(1, 1, At, B1); PG8_BAR; PG8_SCHED;
            } else {
            PG8_LDB(B0, 0, 0); PG8_SCHED; PG8_LDA(At, 0, 0); PG8_STAGE(PG8_SA(1, 1), a1 + hstepA, voffA);
            PG8_WAIT_L(8); PG8_BAR; PG8_WAIT_L(0); PG8_MMA(0, 0, At, B0); PG8_BAR; PG8_SCHED;
            PG8_LDB(B1, 0, 1); PG8_STAGE(PG8_SB(0, 0), b2, voffB);
            PG8_BAR; PG8_WAIT_L(0); PG8_MMA(0, 1, At, B1); PG8_BAR;
            PG8_LDA(At, 0, 1); PG8_STAGE(PG8_SA(0, 0), a2, voffA);
            PG8_BAR; PG8_WAIT_L(0); PG8_MMA(1, 0, At, B0); PG8_BAR; PG8_SCHED;
            PG8_STAGE(PG8_SB(0, 1), b2 + hstepB, voffB);
            PG8_WAIT_V(6); PG8_BAR; PG8_MMA(1, 1, At, B1); PG8_BAR;
            PG8_LDB(B0, 1, 0); PG8_SCHED; PG8_LDA(At, 1, 0); PG8_STAGE(PG8_SA(0, 1), a2 + hstepA, voffA);
            PG8_WAIT_L(8); PG8_BAR; PG8_WAIT_L(0); PG8_MMA(0, 0, At, B0); PG8_BAR; PG8_SCHED;
            PG8_LDB(B1, 1, 1); PG8_STAGE(PG8_SB(1, 0), b3, voffB);
            PG8_BAR; PG8_WAIT_L(0); PG8_MMA(0, 1, At, B1); PG8_BAR;
            PG8_LDA(At, 1, 1); PG8_STAGE(PG8_SA(1, 0), a3, voffA);
            PG8_BAR; PG8_WAIT_L(0); PG8_MMA(1, 0, At, B0); PG8_BAR; PG8_SCHED;
            PG8_STAGE(PG8_SB(1, 1), b3 + hstepB, voffB);
            PG8_WAIT_V(6); PG8_BAR; PG8_MMA(1, 1, At, B1); PG8_BAR;
            }
        }
        if constexpr (ALIGN_EPI) { if (wr == 0) PG8_BAR; }
        E(acc, cur, wr, wc, fr, fq); S.done(cur);
        if (!has_next) break;
#pragma unroll
        for (int a = 0; a < 2; ++a)
#pragma unroll
            for (int b = 0; b < 2; ++b)
#pragma unroll
                for (int m = 0; m < 4; ++m)
#pragma unroll
                    for (int n = 0; n < 2; ++n) acc[a][b][m][n] = (f32x4){0.f, 0.f, 0.f, 0.f};
        cur = nxt; cA = nA; cB = nB; ++ui;
        if constexpr (ALIGN_EPI) { if (wr == 1) PG8_BAR; }
    }
    PG8_WAIT_V(0);
    if constexpr (!ALIGN_EPI) { if (wr == 0) PG8_BAR; }
    PG8_BAR;
#undef PG8_SA
#undef PG8_SB
#undef PG8_STAGE
#undef PG8_LDA
#undef PG8_LDB
#undef PG8_MMA
#undef PG8_WAIT_V
#undef PG8_WAIT_L
#undef PG8_BAR
#undef PG8_SCHED
}
}

namespace att {
#define ATT_LAS __attribute__((address_space(3)))
typedef unsigned short bf16;
typedef short bf16x8 __attribute__((ext_vector_type(8)));
typedef short s16x4 __attribute__((ext_vector_type(4)));
typedef float f32x16 __attribute__((ext_vector_type(16)));
typedef float f32x4 __attribute__((ext_vector_type(4)));
typedef unsigned u32x4 __attribute__((ext_vector_type(4)));
constexpr float SCALE = 0.07216878364870322f;
constexpr float THR = 8.f;
constexpr int SHM_V = 16384, SHM_KN = 16384, SHM_KR = 8192, BUF = SHM_V + SHM_KN + SHM_KR, NBUF = 3;
constexpr int OFF_V = 0, OFF_KN = SHM_V, OFF_KR = SHM_V + SHM_KN, OFF_WS = NBUF * BUF, ATT_LDS_BYTES = OFF_WS + 8 * 256;
#define SBAR() __builtin_amdgcn_sched_barrier(0)
__device__ __forceinline__ int v_st(int k, int c) { const int kk = (k & ~0xC) | ((k & 4) << 1) | ((k & 8) >> 1); return ((kk >> 3) * 4 + (c >> 5)) * 512 + ((kk & 7) * 32 + (c & 31)) * 2; }
__device__ __forceinline__ int v_rd_base(int lane) { return ((lane & 3) << 3) | (((lane >> 2) & 3) << 6) | (((lane >> 4) & 1) << 5) | (((lane >> 5) & 1) << 8); }
constexpr int v_rd_off(int d0, int ks, int half) { return d0 * 512 + ks * 4096 + half * 2048; }
__device__ __forceinline__ int crow(int r, int hi) { return (r & 3) + 8 * (r >> 2) + 4 * hi; }
__device__ __forceinline__ unsigned cvtpk(float lo, float hi) { unsigned r; asm volatile("v_cvt_pk_bf16_f32 %0, %1, %2" : "=v"(r) : "v"(lo), "v"(hi)); return r; }

__device__ __forceinline__ void partialSM(f32x16& p0, f32x16& p1, float& m_reg, float& mn, float& alpha) {
    float pmax = p0[0];
#pragma unroll
    for (int r = 1; r < 16; ++r) pmax = fmaxf(pmax, p0[r]);
#pragma unroll
    for (int r = 0; r < 16; ++r) pmax = fmaxf(pmax, p1[r]);
    { auto rr = __builtin_amdgcn_permlane32_swap(__float_as_uint(pmax), __float_as_uint(pmax), false, false);
      pmax = fmaxf(__uint_as_float(rr[0]), __uint_as_float(rr[1])); }
    constexpr float C2 = 1.4426950408889634f * SCALE;
    if (__builtin_expect(__all((pmax - m_reg) * SCALE <= THR), 1)) { mn = m_reg; alpha = 1.f; }
    else { mn = fmaxf(m_reg, pmax); alpha = __builtin_amdgcn_exp2f((m_reg - mn) * C2); m_reg = mn; }
    const float mnL = -mn * C2;
#pragma unroll
    for (int r = 0; r < 16; ++r) p0[r] = fmaf(p0[r], C2, mnL);
#pragma unroll
    for (int r = 0; r < 16; ++r) p1[r] = fmaf(p1[r], C2, mnL);
#pragma unroll
    for (int r = 0; r < 16; ++r) p0[r] = __builtin_amdgcn_exp2f(p0[r]);
}
__device__ __forceinline__ void finishSM(f32x16& p0, f32x16& p1, float alpha, float& l_reg, bf16x8& pa0, bf16x8& pa1, bf16x8& pa2, bf16x8& pa3) {
#pragma unroll
    for (int r = 0; r < 16; ++r) p1[r] = __builtin_amdgcn_exp2f(p1[r]);
    float ps = 0;
#pragma unroll
    for (int r = 0; r < 16; ++r) ps += p0[r];
#pragma unroll
    for (int r = 0; r < 16; ++r) ps += p1[r];
    { auto rr = __builtin_amdgcn_permlane32_swap(__float_as_uint(ps), __float_as_uint(ps), false, false);
      ps = __uint_as_float(rr[0]) + __uint_as_float(rr[1]); }
    l_reg = l_reg * alpha + ps;
#define PK4(P, B_, OUT) do { unsigned a0 = cvtpk(P[B_+0], P[B_+1]), a1 = cvtpk(P[B_+2], P[B_+3]);                          \
        unsigned b0 = cvtpk(P[B_+4], P[B_+5]), b1 = cvtpk(P[B_+6], P[B_+7]);                                             \
        auto r0 = __builtin_amdgcn_permlane32_swap(a0, b0, false, false); auto r1 = __builtin_amdgcn_permlane32_swap(a1, b1, false, false); \
        u32x4 w = {r0[0], r1[0], r0[1], r1[1]}; OUT = *reinterpret_cast<bf16x8*>(&w); } while (0)
    PK4(p0, 0, pa0); PK4(p0, 8, pa1); PK4(p1, 0, pa2); PK4(p1, 8, pa3);
#undef PK4
}
__device__ __forceinline__ void qkt(f32x16& p0, f32x16& p1, ATT_LAS const char* buf, int r32, int hi, const bf16x8* qr) {
    p0 = f32x16{}; p1 = f32x16{};
    ATT_LAS const char* kn = buf + OFF_KN + r32 * 256; const int xn = (r32 & 15) << 4;
    ATT_LAS const char* kr = buf + OFF_KR + r32 * 128; const int xr = ((r32 >> 1) & 7) << 4;
#define QK_ADDR(s) ((s) < 8 ? kn + (((s) * 32 + hi * 16) ^ xn) : kr + ((((s) - 8) * 32 + hi * 16) ^ xr))
#define QK_LD(X, s0) do { _Pragma("unroll") for (int i_ = 0; i_ < 3; ++i_) { ATT_LAS const char* a_ = QK_ADDR((s0) + i_); X##a[i_] = *(ATT_LAS const bf16x8*)a_; \
        X##b[i_] = *(ATT_LAS const bf16x8*)(a_ + ((s0) + i_ < 8 ? 32 * 256 : 32 * 128)); } } while (0)
#define QK_MM(X, s0) do { _Pragma("unroll") for (int i_ = 0; i_ < 3; ++i_) { p0 = __builtin_amdgcn_mfma_f32_32x32x16_bf16(X##a[i_], qr[(s0) + i_], p0, 0, 0, 0); \
        p1 = __builtin_amdgcn_mfma_f32_32x32x16_bf16(X##b[i_], qr[(s0) + i_], p1, 0, 0, 0); } } while (0)
    bf16x8 Xa[3], Xb[3], Ya[3], Yb[3];
    QK_LD(X, 0); QK_LD(Y, 3); SBAR();
    QK_MM(X, 0); SBAR(); QK_LD(X, 6); SBAR();
    QK_MM(Y, 3); SBAR(); QK_LD(Y, 9); SBAR();
    QK_MM(X, 6); SBAR();
    QK_MM(Y, 9);
#undef QK_ADDR
#undef QK_LD
#undef QK_MM
}
__device__ __forceinline__ void pv_tile(f32x16* o, int vb, bf16x8 pa0, bf16x8 pa1, bf16x8 pa2, bf16x8 pa3) {
#define TRRD(dst, off) asm volatile("ds_read_b64_tr_b16 %0, %1 offset:%2" : "=&v"(dst) : "v"(vb), "i"(off) : "memory")
#define PV_LD(S, d0) do { constexpr int b_ = v_rd_off(d0, 0, 0); TRRD(S##l0, b_); TRRD(S##h0, b_ + 2048); TRRD(S##l1, b_ + 4096); TRRD(S##h1, b_ + 6144); \
        TRRD(S##l2, b_ + 8192); TRRD(S##h2, b_ + 10240); TRRD(S##l3, b_ + 12288); TRRD(S##h3, b_ + 14336); } while (0)
#define PV_MM(S, d0) do { \
        o[d0] = __builtin_amdgcn_mfma_f32_32x32x16_bf16(pa0, (bf16x8){S##l0[0], S##l0[1], S##l0[2], S##l0[3], S##h0[0], S##h0[1], S##h0[2], S##h0[3]}, o[d0], 0, 0, 0);   \
        o[d0] = __builtin_amdgcn_mfma_f32_32x32x16_bf16(pa1, (bf16x8){S##l1[0], S##l1[1], S##l1[2], S##l1[3], S##h1[0], S##h1[1], S##h1[2], S##h1[3]}, o[d0], 0, 0, 0);   \
        o[d0] = __builtin_amdgcn_mfma_f32_32x32x16_bf16(pa2, (bf16x8){S##l2[0], S##l2[1], S##l2[2], S##l2[3], S##h2[0], S##h2[1], S##h2[2], S##h2[3]}, o[d0], 0, 0, 0);   \
        o[d0] = __builtin_amdgcn_mfma_f32_32x32x16_bf16(pa3, (bf16x8){S##l3[0], S##l3[1], S##l3[2], S##l3[3], S##h3[0], S##h3[1], S##h3[2], S##h3[3]}, o[d0], 0, 0, 0); } while (0)
#define PV_W(n) do { asm volatile("s_waitcnt lgkmcnt(" #n ")" ::: "memory"); SBAR(); } while (0)
    s16x4 Al0, Al1, Al2, Al3, Ah0, Ah1, Ah2, Ah3, Bl0, Bl1, Bl2, Bl3, Bh0, Bh1, Bh2, Bh3;
    PV_LD(A, 0); PV_LD(B, 1); PV_W(8); PV_MM(A, 0); SBAR();
    PV_LD(A, 2); PV_W(8); PV_MM(B, 1); SBAR();
    PV_LD(B, 3); PV_W(8); PV_MM(A, 2); SBAR();
    PV_W(0); PV_MM(B, 3);
#undef PV_W
#undef PV_MM
#undef PV_LD
#undef TRRD
}
__device__ __forceinline__ void attn_unit(ATT_LAS char* lds, const bf16* Q, const bf16* KV, const bf16* KRP, bf16* O, int h, int qb) {
    int tz = threadIdx.x; asm volatile("" : "+v"(tz));
    const int tid = tz, wid = __builtin_amdgcn_readfirstlane(tid >> 6), lane = tid & 63, r32 = lane & 31, hi = lane >> 5;
    const int ntw = 4 * qb + (wid >> 1) + 1, NT = 4 * qb + 4;
    bf16x8 qr[12];
    { const bf16* qrow = Q + (size_t)(qb * 256 + wid * 32 + r32) * 3072 + h * 192;
#pragma unroll
      for (int d0 = 0; d0 < 8; ++d0) qr[d0] = *(const bf16x8*)(qrow + d0 * 16 + hi * 8);
#pragma unroll
      for (int d0 = 0; d0 < 4; ++d0) qr[8 + d0] = *(const bf16x8*)(qrow + 128 + d0 * 16 + hi * 8); }
    ATT_LAS float* ws = (ATT_LAS float*)(lds + OFF_WS) + wid * 64; ATT_LAS float* li_l = ws; ATT_LAS float* al_l = ws + 32;
    float m_reg = -1e30f, l_reg = 0.f; f32x16 o[4] = {};
    unsigned offKN[2], offV[2], offKR;
#pragma unroll
    for (int i = 0; i < 2; ++i) { const int p = (wid * 2 + i) * 64 + lane; const int row = p >> 4, j = (p & 15) ^ (row & 15); offKN[i] = (unsigned)(row * 4096 + j * 8) * 2u;
        const int sub = p >> 5, q = p & 31, kk = (sub >> 2) * 8 + (q >> 2), col = (sub & 3) * 32 + (q & 3) * 8, key = (kk & ~0xC) | ((kk & 4) << 1) | ((kk & 8) >> 1);
        offV[i] = (unsigned)(key * 4096 + 128 + col) * 2u; }
    { const int p = wid * 64 + lane, row = p >> 3, j = (p & 7) ^ ((row >> 1) & 7); offKR = (unsigned)(row * 64 + j * 8) * 2u; }
    const int vb0 = (int)(uintptr_t)(lds + OFF_V) + v_rd_base(lane);
    const char* kvh = (const char*)(KV + h * 256);
    const bool grpB = wid >= 4;
#define ATT_GLDS(g, l) __builtin_amdgcn_global_load_lds((const unsigned*)(g), (ATT_LAS unsigned*)(l), 16, 0, 0)
#define ATT_DMA(bo, t) do { const char* kb_ = kvh + (size_t)(t) * (64 * 4096 * 2); const char* rb_ = (const char*)KRP + (size_t)(t) * (64 * 64 * 2); ATT_LAS char* l_ = lds + (bo);  \
        ATT_GLDS(kb_ + offKN[0], l_ + OFF_KN + (wid * 2 + 0) * 1024); ATT_GLDS(kb_ + offKN[1], l_ + OFF_KN + (wid * 2 + 1) * 1024); \
        ATT_GLDS(kb_ + offV[0], l_ + OFF_V + (wid * 2 + 0) * 1024); ATT_GLDS(kb_ + offV[1], l_ + OFF_V + (wid * 2 + 1) * 1024);       \
        ATT_GLDS(rb_ + offKR, l_ + OFF_KR + wid * 1024); } while (0)
#define ATT_RESC(a) do { if (__any((a) < 1.f)) { if (hi == 0) al_l[r32] = (a); asm volatile("s_waitcnt lgkmcnt(0)" ::: "memory");              \
        _Pragma("unroll") for (int d_ = 0; d_ < 4; ++d_) _Pragma("unroll") for (int r = 0; r < 16; ++r) o[d_][r] *= al_l[crow(r, hi)]; } } while (0)
#define ATT_BAR() asm volatile("s_barrier" ::: "memory")
#define ATT_WAIT_BAR() asm volatile("s_waitcnt vmcnt(0)\n\ts_barrier" ::: "memory")
    ATT_DMA(0, 0); ATT_DMA(BUF, 1);
    asm volatile("s_waitcnt vmcnt(5)" ::: "memory");
    if (grpB) ATT_BAR();
    int bo = 0, bo2 = 2 * BUF;
    for (int t = 0; t < NT; ++t) {
        f32x16 p0, p1; float mn, alpha; bf16x8 pa0, pa1, pa2, pa3;
        ATT_BAR();
        if (t < ntw) { qkt(p0, p1, lds + bo, r32, hi, qr); partialSM(p0, p1, m_reg, mn, alpha); }
        ATT_WAIT_BAR();
        if (t + 2 < NT) ATT_DMA(bo2, t + 2);
        if (t < ntw) { ATT_RESC(alpha); finishSM(p0, p1, alpha, l_reg, pa0, pa1, pa2, pa3); SBAR(); pv_tile(o, vb0 + bo, pa0, pa1, pa2, pa3); }
        bo = (bo == 2 * BUF) ? 0 : bo + BUF; bo2 = (bo2 == 2 * BUF) ? 0 : bo2 + BUF;
    }
    if (!grpB) ATT_BAR();
    if (hi == 0) li_l[r32] = l_reg; asm volatile("s_waitcnt lgkmcnt(0)" ::: "memory");
    bf16* Ow = O + (size_t)(qb * 256 + wid * 32) * 2048 + h * 128;
#pragma unroll
    for (int r = 0; r < 16; ++r) { const int orow = crow(r, hi); const float rl = __builtin_amdgcn_rcpf(li_l[orow]);
#pragma unroll
        for (int d0 = 0; d0 < 4; ++d0) { const float v = o[d0][r] * rl; const float vn = __shfl_xor(v, 1);
            if ((r32 & 1) == 0) *(unsigned*)(Ow + (size_t)orow * 2048 + d0 * 32 + r32) = cvtpk(v, vn); } }
    __syncthreads();
#undef ATT_BAR
#undef ATT_WAIT_BAR
#undef ATT_GLDS
#undef ATT_DMA
#undef ATT_RESC
#undef ATT_STEP
}
#undef SBAR
}

constexpr int NWAVES = 8;
constexpr int S_ = 8192, D_ = 4096, NZ = 3840, INW = 3648, NGATE = 8192, N1 = NZ + NGATE, PW = 2048, QLAT = 1024, KVLAT = 512, KROPE = 64;
constexpr int O1 = 2048, O2 = 3072, O3 = 3584;
constexpr int NHEAD = 16, NQ = 3072, NKV = 4096, MLAW = 2048, FF = 11008, NF1 = 2 * FF, PLE = 256;
constexpr float EPS = 1e-6f;
constexpr size_t MiB = 1u << 20;
constexpr size_t WS_CTL = 0, CTL_ZERO_BYTES = 1 * MiB;
constexpr size_t WS_W1 = 2 * MiB, WS_WPOOL = 96 * MiB, WS_WQ = 98 * MiB, WS_WKV = 104 * MiB, WS_WUPA = 108 * MiB, WS_WUPB = 124 * MiB, WS_WOUT = 140 * MiB,
                 WS_WF1 = 172 * MiB, WS_WF2 = 344 * MiB, WS_WPG = 430 * MiB, WS_WPP = 462 * MiB;
constexpr size_t WS_RA = 464 * MiB;
constexpr size_t WS_Z = 592 * MiB;
constexpr size_t WS_POOLED = 652 * MiB;
constexpr size_t WS_TMP = 592 * MiB;
constexpr size_t WS_RC = 720 * MiB;
constexpr size_t WS_Q = 784 * MiB, WS_KV = 832 * MiB, WS_MIXED = 896 * MiB, WS_MLAO = 928 * MiB;
constexpr size_t WS_ACT = 784 * MiB;
constexpr size_t WS_PBF = 960 * MiB, WS_COS = 964 * MiB, WS_SIN = 965 * MiB, WS_KROPE = 966 * MiB, WS_RSTD = 967 * MiB, WS_END = 968 * MiB;
static_assert(WS_ACT + (size_t)S_ * FF * 2 <= WS_PBF && WS_W1 + (size_t)N1 * D_ * 2 <= WS_WPOOL && WS_WF1 + (size_t)NF1 * D_ * 2 <= WS_WF2 && WS_WF2 + (size_t)D_ * FF * 2 <= WS_WPG, "d_ws map");
constexpr int CW_BAR = 4096;
constexpr int RING_BYTES = 131072, LDSCTL_OFF = RING_BYTES, MISC_OFF = LDSCTL_OFF + 320, LDS_BYTES = 147456;
static_assert(att::ATT_LDS_BYTES <= RING_BYTES, "attention LDS");

#define GAS __attribute__((address_space(1)))
#define LAS __attribute__((address_space(3)))
typedef unsigned short bf16;
typedef unsigned v4u __attribute__((ext_vector_type(4)));
typedef unsigned v2u __attribute__((ext_vector_type(2)));
typedef float f32x4 __attribute__((ext_vector_type(4)));
typedef GAS unsigned gu32;
#define RLX_AGENT __ATOMIC_RELAXED, __HIP_MEMORY_SCOPE_AGENT
#define LDS_WAIT() asm volatile("s_waitcnt lgkmcnt(0)" ::: "memory")
__device__ __forceinline__ unsigned f2bf(float f) { unsigned u = __builtin_bit_cast(unsigned, f); return (u + 0x7fffu + ((u >> 16) & 1u)) >> 16; }
__device__ __forceinline__ unsigned pk2(float lo, float hi) { return f2bf(lo) | (f2bf(hi) << 16); }
__device__ __forceinline__ float bflo(unsigned w) { return __uint_as_float(w << 16); }
__device__ __forceinline__ float bfhi(unsigned w) { return __uint_as_float(w & 0xffff0000u); }

#define XB_TMO      128
#define XB_XCNT(j)  (256  + 64 * (j))
#define XB_XSUB(j)  (1280 + 64 * (j))
#define XB_XGEN(j)  (2304 + 64 * (j))
#define XB_TOP      3328
#define XB_TOPGEN   3392
#define XCD_BAR_WORDS 3456
#define XB_SPIN_CAP (1u << 18)
__device__ __forceinline__ unsigned xb_ld(unsigned* p)              { return __hip_atomic_load(p, __ATOMIC_RELAXED, __HIP_MEMORY_SCOPE_AGENT); }
__device__ __forceinline__ unsigned xb_add(unsigned* p, unsigned v) { return __hip_atomic_fetch_add(p, v, __ATOMIC_RELAXED, __HIP_MEMORY_SCOPE_AGENT); }
__device__ __forceinline__ unsigned xb_xcc_id() { return (unsigned)__builtin_amdgcn_s_getreg((3 << 11) | 20) & 0xFu; }
#define XB_SPIN(cond, bar) do { unsigned _sp = 0; while (cond) { __builtin_amdgcn_s_sleep(1); \
    if ((++_sp & 255u) == 0u) { if (xb_ld(&(bar)[XB_TMO])) break; if (_sp > XB_SPIN_CAP) { atomicAdd(&(bar)[XB_TMO], 1u); break; } } } } while (0)
struct XcdBarrier { unsigned* bar; unsigned x; volatile LAS unsigned* st; };
__device__ __forceinline__ XcdBarrier xcd_barrier_post(unsigned* bar, volatile LAS unsigned* st) {
    XcdBarrier b; b.bar = bar; b.x = xb_xcc_id(); b.st = st;
    if (threadIdx.x == 0) (void)xb_add(&bar[XB_XCNT(b.x)], 1u);
    return b;
}
__device__ __forceinline__ void xcd_barrier_complete(unsigned* bar, unsigned x, unsigned& nloc, unsigned& nx) {
    const unsigned G = gridDim.x * gridDim.y * gridDim.z;
    unsigned sum, cnt, mine, sp = 0u;
    for (;;) {
        sum = 0u; cnt = 0u; mine = 0u;
#pragma unroll
        for (unsigned j = 0; j < 16; ++j) { const unsigned c = xb_ld(&bar[XB_XCNT(j)]); sum += c; cnt += (c > 0u) ? 1u : 0u; mine = (j == x) ? c : mine; }
        if (sum == G) break;
        __builtin_amdgcn_s_sleep(1);
        if ((++sp & 255u) == 0u) { if (xb_ld(&bar[XB_TMO])) break; if (sp > XB_SPIN_CAP) { atomicAdd(&bar[XB_TMO], 1u); break; } }
    }
    nloc = mine > 0u ? mine : 1u; nx = cnt > 0u ? cnt : 1u;
}
__device__ __forceinline__ void xcd_barrier(const XcdBarrier& b) {
    asm volatile("s_waitcnt vmcnt(0)" ::: "memory");
    __syncthreads();
    if (threadIdx.x == 0) {
        unsigned* bar = b.bar;
        __builtin_amdgcn_s_waitcnt(0);
        unsigned nloc = b.st[0], nx = b.st[1];
        if (nloc == 0u) { xcd_barrier_complete(bar, b.x, nloc, nx); b.st[0] = nloc; b.st[1] = nx; }
        const unsigned old = xb_add(&bar[XB_XSUB(b.x)], 1u);
        const unsigned gen = old / nloc;
        if (old + 1u == (gen + 1u) * nloc) {
            __builtin_amdgcn_fence(__ATOMIC_RELEASE, "agent");
            asm volatile("s_waitcnt vmcnt(0)" ::: "memory");
            const unsigned og = xb_add(&bar[XB_TOP], 1u);
            const unsigned tg = og / nx;
            if (og + 1u == (tg + 1u) * nx) xb_add(&bar[XB_TOPGEN], 1u);
            else XB_SPIN(xb_ld(&bar[XB_TOPGEN]) == tg, bar);
            __builtin_amdgcn_fence(__ATOMIC_ACQUIRE, "agent");
            xb_add(&bar[XB_XGEN(b.x)], 1u);
            asm volatile("s_waitcnt vmcnt(0)" ::: "memory");
        } else {
            XB_SPIN(xb_ld(&bar[XB_XGEN(b.x)]) == gen, bar);
            __builtin_amdgcn_fence(__ATOMIC_ACQUIRE, "agent");
            asm volatile("s_waitcnt vmcnt(0)" ::: "memory");
        }
    }
    __syncthreads();
}

__device__ __forceinline__ float wave_sum(float v) {
#pragma unroll
    for (int o = 1; o < 64; o <<= 1) v += __shfl_xor(v, o);
    return v;
}
struct TDesc { const float* src; const float* kscale; bf16* drow; int ldw, k0, perm, K; };
__device__ __forceinline__ TDesc tp_resolve(const float* W, const float* W2, const float* kscale, bf16* WT, int K, int Nd, int ldw, int kind, int item, int lane) {
    const int nblk = Nd / 64, kb = item / nblk, nb = item - kb * nblk, k0 = 64 * kb, n0 = 64 * nb;
    const int r = lane >> 4, c4 = (lane & 15) * 4;
    TDesc d; const float* src;
    if (kind == 1) { const int n = n0 + c4, q = n >> 3, s = (n >> 2) & 1; src = (s ? W2 : W) + 4 * q; }
    else src = W + n0 + c4;
    d.src = src + (size_t)(k0 + 2 * r) * ldw; d.kscale = kscale; d.drow = WT + (size_t)(n0 + (lane >> 3)) * K + k0; d.K = K; d.ldw = ldw; d.k0 = k0; d.perm = (kind == 2 && (nb % 3) == 2) ? 1 : 0;
    return d;
}
__device__ __forceinline__ void tp_load(const TDesc& d, f32x4 (&v)[16]) {
#pragma unroll
    for (int i = 0; i < 16; ++i) v[i] = *(const GAS f32x4*)(d.src + (size_t)(8 * (i >> 1) + (i & 1)) * d.ldw);
}
__device__ __forceinline__ void tp_finish(const TDesc& d, f32x4 (&v)[16], LAS unsigned* scr, int lane) {
    const int r = lane >> 4, c4 = (lane & 15) * 4;
    if (d.kscale) {
#pragma unroll
        for (int i = 0; i < 16; ++i) v[i] = v[i] * d.kscale[d.k0 + 8 * (i >> 1) + 2 * r + (i & 1)];
    }
#pragma unroll
    for (int m = 0; m < 8; ++m) { const f32x4 a = v[2 * m], b = v[2 * m + 1]; v4u w; w.x = pg8::cvt_pk_bf16(a.x, b.x); w.y = pg8::cvt_pk_bf16(a.y, b.y); w.z = pg8::cvt_pk_bf16(a.z, b.z); w.w = pg8::cvt_pk_bf16(a.w, b.w);
        *(LAS v4u*)(scr + (4 * m + r) * 68 + c4) = w; }
    LDS_WAIT(); asm volatile("" ::: "memory");
    const int kc = lane & 7, nl = lane >> 3;
#pragma unroll
    for (int j = 0; j < 8; ++j) { const int n = nl + 8 * j, ncol = d.perm ? 32 * (n & 1) + (n >> 1) : n; const LAS unsigned* s = scr + (4 * kc) * 68 + ncol;
        v4u o; o.x = s[0]; o.y = s[68]; o.z = s[136]; o.w = s[204]; *(GAS v4u*)(d.drow + (size_t)(8 * j) * d.K + 8 * kc) = o; }
    LDS_WAIT(); asm volatile("" ::: "memory");
}

struct Args { const float* in[25]; const int* pos; float* out; unsigned char* ws; };
__device__ __forceinline__ unsigned long long karg_u64(int off) { auto kp = (const __attribute__((address_space(4))) unsigned char*)__builtin_amdgcn_kernarg_segment_ptr(); asm volatile("" : "+s"(kp));
    return *(const __attribute__((address_space(4))) unsigned long long*)(kp + off); }

#define ROWF_LD4(base, i, h) (*(const GAS f32x4*)((const GAS char*)(base) + ((i) >> 1) * 4096 + lo32 + ((i) & 1) * 2048 + (h) * 16))
#define ROWF_ST4(base, i, h) (*(GAS f32x4*)((GAS char*)(base) + ((i) >> 1) * 4096 + lo32 + ((i) & 1) * 2048 + (h) * 16))
#define ROWB_LD8(base, i) (*(const GAS v4u*)((const GAS char*)(base) + ((i) >> 2) * 4096 + lo16 + ((i) & 3) * 1024))
#define ROWB_ST8(base, i) (*(GAS v4u*)((GAS char*)(base) + ((i) >> 2) * 4096 + lo16 + ((i) & 3) * 1024))
#define GAIN_LD4(gl, i, h) (*(const LAS f32x4*)((const LAS char*)(gl) + (i) * 2048 + lo32 + (h) * 16))
__device__ __forceinline__ float sq4(f32x4 a) { return (a.x * a.x + a.y * a.y) + (a.z * a.z + a.w * a.w); }
template <bool HN>
__device__ __forceinline__ void norm_row(const bf16* y, const float* xi, float* xo, const LAS float* g1, const LAS float* g2, bf16* hn, int lane) {
    const unsigned lo32 = (unsigned)lane * 32u, lo16 = (unsigned)lane * 16u;
    f32x4 v[16]; float ss = 0.f;
#pragma unroll
    for (int i = 0; i < 8; ++i) { const v4u c = ROWB_LD8(y, i); v[2 * i] = (f32x4){bflo(c.x), bfhi(c.x), bflo(c.y), bfhi(c.y)}; v[2 * i + 1] = (f32x4){bflo(c.z), bfhi(c.z), bflo(c.w), bfhi(c.w)};
        ss += sq4(v[2 * i]) + sq4(v[2 * i + 1]); }
    const float rstd = 1.0f / sqrtf(wave_sum(ss) * (1.0f / D_) + EPS);
    float s2 = 0.f;
#pragma unroll
    for (int i = 0; i < 8; ++i)
#pragma unroll
        for (int h = 0; h < 2; ++h) { const f32x4 xv = ROWF_LD4(xi, i, h), gv = GAIN_LD4(g1, i, h); v[2 * i + h] = xv + v[2 * i + h] * rstd * gv; s2 += sq4(v[2 * i + h]); }
#pragma unroll
    for (int i = 0; i < 8; ++i)
#pragma unroll
        for (int h = 0; h < 2; ++h) ROWF_ST4(xo, i, h) = v[2 * i + h];
    if constexpr (HN) {
        const float rstd2 = 1.0f / sqrtf(wave_sum(s2) * (1.0f / D_) + EPS);
#pragma unroll
        for (int i = 0; i < 8; ++i) { const f32x4 a = v[2 * i] * rstd2 * GAIN_LD4(g2, i, 0), b = v[2 * i + 1] * rstd2 * GAIN_LD4(g2, i, 1);
            v4u w; w.x = pk2(a.x, a.y); w.y = pk2(a.z, a.w); w.z = pk2(b.x, b.y); w.w = pk2(b.z, b.w); ROWB_ST8(hn, i) = w; }
    }
}
__device__ __forceinline__ void prenorm_row(const float* xrow, const LAS float* g, bf16* hn, int lane) {
    const unsigned lo32 = (unsigned)lane * 32u, lo16 = (unsigned)lane * 16u;
    f32x4 v[16]; float ss = 0.f;
#pragma unroll
    for (int i = 0; i < 8; ++i)
#pragma unroll
        for (int h = 0; h < 2; ++h) { v[2 * i + h] = ROWF_LD4(xrow, i, h); ss += sq4(v[2 * i + h]); }
    const float rstd = 1.0f / sqrtf(wave_sum(ss) * (1.0f / D_) + EPS);
#pragma unroll
    for (int i = 0; i < 8; ++i) { const f32x4 a = v[2 * i] * rstd * GAIN_LD4(g, i, 0), b = v[2 * i + 1] * rstd * GAIN_LD4(g, i, 1);
        v4u w; w.x = pk2(a.x, a.y); w.y = pk2(a.z, a.w); w.z = pk2(b.x, b.y); w.w = pk2(b.z, b.w); ROWB_ST8(hn, i) = w; }
}
__device__ __forceinline__ void stage_gain(LAS unsigned char* lds, int off, const float* g, int) {
    int tz = threadIdx.x; asm volatile("" : "+v"(tz));
    for (int i = tz; i < D_ / 4; i += NWAVES * 64) *(LAS f32x4*)(lds + off + i * 16) = *(const GAS f32x4*)(g + i * 4);
}

#ifndef PHASE_MASK
#define PHASE_MASK 0xFFFF
#endif
#define PH(k) constexpr ((PHASE_MASK >> (k)) & 1)
#ifndef REP_PHASE
#define REP_PHASE -1
#endif
#define NREP(k) (((k) == REP_PHASE) ? 2 : 1)
__global__ void __launch_bounds__(NWAVES * 64, 2) fwd_kernel(Args args) {
    extern __shared__ __attribute__((aligned(16))) unsigned char lds_raw[];
    LAS unsigned char* lds = (LAS unsigned char*)lds_raw;
    volatile LAS unsigned* MISC = (volatile LAS unsigned*)(lds + MISC_OFF);
    const int tid = threadIdx.x, lane = tid & 63, wave = __builtin_amdgcn_readfirstlane(tid >> 6);
    const int G = gridDim.x, bx = blockIdx.x;
    const int vcu = (G % 8 == 0) ? (bx % 8) * (G / 8) + bx / 8 : bx;
    const int gw = vcu * NWAVES + wave, NGW = G * NWAVES;
    (void)args;
#define INP(i) ((const float*)(const GAS float*)karg_u64(8 * (i)))
#define WSB ((unsigned char*)(GAS unsigned char*)karg_u64(216))
#define OUTP ((float*)(GAS float*)karg_u64(208))
    for (int u = tid; u < (LDS_BYTES - LDSCTL_OFF) / 4; u += NWAVES * 64) ((LAS unsigned*)(lds + LDSCTL_OFF))[u] = 0u;
    __syncthreads();
    XcdBarrier bar = xcd_barrier_post((unsigned*)(WSB + WS_CTL) + CW_BAR, MISC + 8);
#define GRID_BAR() xcd_barrier(bar)

#define WSP(T, off) ((T*)(WSB + (off)))
#pragma unroll 1
    for (int rep_ = 0; rep_ < NREP(0); ++rep_) {
    if PH(0) {
        LAS unsigned* scr = (LAS unsigned*)(lds + wave * 16384);
        constexpr int I_IN = (D_ / 64) * (INW / 64), I_G = (D_ / 64) * (NGATE / 64), I_POOL1 = (512 / 64) * (512 / 64), I_Q = (QLAT / 64) * (NQ / 64), I_KV = (KVLAT / 64) * (NKV / 64),
                      I_UP = (PW / 64) * (D_ / 64), I_OUT = (D_ / 64) * (D_ / 64), I_F1 = (D_ / 64) * (NF1 / 64), I_F2 = (FF / 64) * (D_ / 64), I_PG = I_OUT, I_PP = (PLE / 64) * (D_ / 64);
        constexpr int NITEMS = I_IN + I_G + 4 * I_POOL1 + I_Q + I_KV + 2 * I_UP + I_OUT + I_F1 + I_F2 + I_PG + I_PP;
#define TP_RESOLVE(it_, d_) do { int r = (it_); const float* W; const float* W2 = nullptr; const float* ks = nullptr; bf16* WT; int K, Nd, ldw, kind = 0;                    \
            if (r < I_F1) { W = INP(18); W2 = INP(19); WT = WSP(bf16, WS_WF1); K = D_; Nd = NF1; ldw = FF; kind = 1; }                                                   \
            else if ((r -= I_F1) < I_F2) { W = INP(20); WT = WSP(bf16, WS_WF2); K = FF; Nd = D_; ldw = D_; }                                                             \
            else if ((r -= I_F2) < I_G) { W = INP(14); WT = WSP(bf16, WS_W1) + (size_t)NZ * D_; K = D_; Nd = NGATE; ldw = NGATE; }                                       \
            else if ((r -= I_G) < I_IN) { W = INP(5); WT = WSP(bf16, WS_W1); K = D_; Nd = INW; ldw = INW; }                                                              \
            else if ((r -= I_IN) < I_OUT) { W = INP(15); WT = WSP(bf16, WS_WOUT); K = D_; Nd = D_; ldw = D_; }                                                           \
            else if ((r -= I_OUT) < I_PG) { W = INP(22); WT = WSP(bf16, WS_WPG); K = D_; Nd = D_; ldw = D_; }                                                            \
            else if ((r -= I_PG) < I_UP) { W = INP(12); WT = WSP(bf16, WS_WUPA); K = PW; Nd = D_; ldw = D_; }                                                            \
            else if ((r -= I_UP) < I_UP) { W = INP(13); WT = WSP(bf16, WS_WUPB); K = MLAW; Nd = D_; ldw = D_; }                                                          \
            else if ((r -= I_UP) < I_Q) { W = INP(8); ks = INP(6); WT = WSP(bf16, WS_WQ); K = QLAT; Nd = NQ; ldw = NQ; kind = 2; }                                       \
            else if ((r -= I_Q) < I_KV) { W = INP(9); ks = INP(7); WT = WSP(bf16, WS_WKV); K = KVLAT; Nd = NKV; ldw = NKV; }                                             \
            else if ((r -= I_KV) < I_PP) { W = INP(23); WT = WSP(bf16, WS_WPP); K = PLE; Nd = D_; ldw = D_; }                                                            \
            else { r -= I_PP; const int g = r / I_POOL1; r -= g * I_POOL1; W = INP(10) + (size_t)g * 512 * 512; WT = WSP(bf16, WS_WPOOL) + (size_t)g * 512 * 512; K = 512; Nd = 512; ldw = 512; } \
            d_ = tp_resolve(W, W2, ks, WT, K, Nd, ldw, kind, r, lane); } while (0)
        { TDesc d0, d1; f32x4 va[16], vb[16]; int it = gw;
          if (it < NITEMS) { TP_RESOLVE(it, d0); tp_load(d0, va); }
          while (it < NITEMS) {
              const int it1 = it + NGW, it2 = it1 + NGW; const bool h1 = it1 < NITEMS, h2 = it2 < NITEMS;
              if (h1) { TP_RESOLVE(it1, d1); tp_load(d1, vb); }
              tp_finish(d0, va, scr, lane);
              if (h2) { TP_RESOLVE(it2, d0); tp_load(d0, va); }
              if (h1) tp_finish(d1, vb, scr, lane);
              it = it2; } }
#undef TP_RESOLVE
        { bf16* W1 = WSP(bf16, WS_W1); const int nchunk = (NZ - INW) * D_ / 8; for (int i = gw * 64 + lane; i < nchunk; i += NGW * 64) *(GAS v4u*)(W1 + (size_t)INW * D_ + (size_t)i * 8) = (v4u){0u, 0u, 0u, 0u}; }
        { __syncthreads(); stage_gain(lds, 0, INP(3), tid); __syncthreads();
          const float* x = INP(0); bf16* RC = WSP(bf16, WS_RC);
          for (int m = gw; m < S_; m += NGW) { asm volatile("" ::: "memory"); prenorm_row(x + (size_t)m * D_, (const LAS float*)lds, RC + (size_t)m * D_, lane); } }
        { const float* p = INP(1); bf16* PBF = WSP(bf16, WS_PBF); const int nchunk = S_ * PLE / 8; for (int i = gw * 64 + lane; i < nchunk; i += NGW * 64) { const f32x4 a = *(const GAS f32x4*)(p + (size_t)i * 8), b = *(const GAS f32x4*)(p + (size_t)i * 8 + 4);
            v4u o; o.x = pk2(a.x, a.y); o.y = pk2(a.z, a.w); o.z = pk2(b.x, b.y); o.w = pk2(b.z, b.w); *(GAS v4u*)(PBF + (size_t)i * 8) = o; } }
        { const int* positions = (const int*)(const GAS int*)karg_u64(200); float* COST = WSP(float, WS_COS); float* SINT = WSP(float, WS_SIN);
        for (int i = gw * 64 + lane; i < S_ * 32; i += NGW * 64) { const int s = i >> 5, k = i & 31; const float inv = powf(10000.0f, -(float)(2 * k) / 64.0f); const float ang = (float)positions[s] * inv;
            COST[i] = cosf(ang); SINT[i] = sinf(ang); } }
    }
    GRID_BAR();
    }

#pragma unroll 1
    for (int rep_ = 0; rep_ < NREP(1); ++rep_) {
    if PH(1) { pg8::Gemm g{WSP(bf16, WS_RC), WSP(bf16, WS_W1), S_, N1, D_, D_, D_}; pg8::StaticOrder so; so.init(S_, N1, G, bx); pg8::EpiZG E{WSP(bf16, WS_Z), WSP(bf16, WS_RA)};
      pg8::gemm_phase<pg8::EpiZG, pg8::StaticOrder, true, true>(lds, g, so, E); }
    GRID_BAR();
    }

#pragma unroll 1
    for (int rep_ = 0; rep_ < NREP(2); ++rep_) {
    if PH(2) {
        const bf16* Z = WSP(bf16, WS_Z); bf16* POOLED = WSP(bf16, WS_POOLED);
        for (int it = gw; it < S_ * 4; it += NGW) { const int t = it >> 2, g = it & 3, w = 2 << g; const int cnt = (t + 1 < w) ? t + 1 : w;
            const bf16* zp = Z + (size_t)t * NZ + g * 512 + lane * 8;
            float a[8];
            const v4u c0 = *(const GAS v4u*)zp;
            a[0] = bflo(c0.x); a[1] = bfhi(c0.x); a[2] = bflo(c0.y); a[3] = bfhi(c0.y); a[4] = bflo(c0.z); a[5] = bfhi(c0.z); a[6] = bflo(c0.w); a[7] = bfhi(c0.w);
            float u0[8];
#pragma unroll
            for (int e = 0; e < 8; ++e) u0[e] = a[e];
            for (int j = 1; j < cnt; ++j) { const v4u c = *(const GAS v4u*)(zp - (size_t)j * NZ);
                a[0] += bflo(c.x); a[1] += bfhi(c.x); a[2] += bflo(c.y); a[3] += bfhi(c.y); a[4] += bflo(c.z); a[5] += bfhi(c.z); a[6] += bflo(c.w); a[7] += bfhi(c.w); }
            const float ic = 1.0f / (float)cnt;
            v4u o; o.x = pk2(a[0] * ic - u0[0], a[1] * ic - u0[1]); o.y = pk2(a[2] * ic - u0[2], a[3] * ic - u0[3]); o.z = pk2(a[4] * ic - u0[4], a[5] * ic - u0[5]); o.w = pk2(a[6] * ic - u0[6], a[7] * ic - u0[7]);
            *(GAS v4u*)(POOLED + (size_t)t * PW + g * 512 + lane * 8) = o; }
        float* RSTDQ = WSP(float, WS_RSTD); float* RSTDKV = RSTDQ + S_; const float* COST = WSP(float, WS_COS); const float* SINT = WSP(float, WS_SIN); bf16* KRP = WSP(bf16, WS_KROPE);
        for (int m = gw; m < S_; m += NGW) { const bf16* zr = Z + (size_t)m * NZ;
            const v4u q0 = *(const GAS v4u*)(zr + O1 + lane * 8), q1 = *(const GAS v4u*)(zr + O1 + 512 + lane * 8), k0 = *(const GAS v4u*)(zr + O2 + lane * 8);
            float sq = 0.f, sk = 0.f;
#define SQ8(c, acc_) do { float t_; t_ = bflo(c.x); acc_ += t_ * t_; t_ = bfhi(c.x); acc_ += t_ * t_; t_ = bflo(c.y); acc_ += t_ * t_; t_ = bfhi(c.y); acc_ += t_ * t_; \
                           t_ = bflo(c.z); acc_ += t_ * t_; t_ = bfhi(c.z); acc_ += t_ * t_; t_ = bflo(c.w); acc_ += t_ * t_; t_ = bfhi(c.w); acc_ += t_ * t_; } while (0)
            SQ8(q0, sq); SQ8(q1, sq); SQ8(k0, sk);
#undef SQ8
            sq = wave_sum(sq); sk = wave_sum(sk);
            if (lane == 0) { RSTDQ[m] = 1.0f / sqrtf(sq * (1.0f / QLAT) + EPS); RSTDKV[m] = 1.0f / sqrtf(sk * (1.0f / KVLAT) + EPS); }
            if (lane < 32) { const float x1 = __uint_as_float((unsigned)zr[O3 + lane] << 16), x2 = __uint_as_float((unsigned)zr[O3 + 32 + lane] << 16);
                const float cs = COST[m * 32 + lane], sn = SINT[m * 32 + lane];
                *(GAS unsigned*)(KRP + (size_t)m * 64 + 2 * lane) = pk2(x1 * cs - x2 * sn, x1 * sn + x2 * cs); } }
    }
    GRID_BAR();
    }

#pragma unroll 1
    for (int rep_ = 0; rep_ < NREP(3); ++rep_) {
    if PH(3) {
#pragma unroll 1
        for (int g = 0; g < 4; ++g) { pg8::Gemm gm{WSP(bf16, WS_POOLED) + g * 512, WSP(bf16, WS_WPOOL) + (size_t)g * 512 * 512, S_, 512, 512, PW, 512}; pg8::StaticOrder so; so.init(S_, 512, G, (bx + 64 * g) % G);
            pg8::EpiBf16Scale E{WSP(bf16, WS_MIXED) + g * 512, PW, INP(11) + g * 512, nullptr};
            pg8::gemm_phase<pg8::EpiBf16Scale, pg8::StaticOrder, true, true>(lds, gm, so, E); }
        { pg8::Gemm gm{WSP(bf16, WS_Z) + O1, WSP(bf16, WS_WQ), S_, NQ, QLAT, NZ, QLAT}; pg8::StaticOrder so; so.init(S_, NQ, G, bx); pg8::EpiQ E{WSP(bf16, WS_Q), WSP(float, WS_RSTD), WSP(float, WS_COS), WSP(float, WS_SIN)};
          pg8::gemm_phase<pg8::EpiQ, pg8::StaticOrder, true, true>(lds, gm, so, E); }
        { pg8::Gemm gm{WSP(bf16, WS_Z) + O2, WSP(bf16, WS_WKV), S_, NKV, KVLAT, NZ, KVLAT}; pg8::StaticOrder so; so.init(S_, NKV, G, bx); pg8::EpiBf16Scale E{WSP(bf16, WS_KV), NKV, nullptr, WSP(float, WS_RSTD) + S_};
          pg8::gemm_phase<pg8::EpiBf16Scale, pg8::StaticOrder, true, true>(lds, gm, so, E); }
    }
    GRID_BAR();
    }

#pragma unroll 1
    for (int rep_ = 0; rep_ < NREP(4); ++rep_) {
    if PH(4) { const bf16* QB = WSP(bf16, WS_Q); const bf16* KVB = WSP(bf16, WS_KV); const bf16* KRP = WSP(bf16, WS_KROPE); bf16* MLAO = WSP(bf16, WS_MLAO);
      for (int pr = bx; pr < 256; pr += G) { const int j = pr >> 3, h = (pr & 7) + 8 * (j >> 4), ql = j & 15;
#pragma unroll 1
        for (int half = 0; half < 2; ++half) att::attn_unit((ATT_LAS char*)lds, QB, KVB, KRP, MLAO, h, half == 0 ? 31 - ql : ql); } }
    GRID_BAR();
    }

#pragma unroll 1
    for (int rep_ = 0; rep_ < NREP(5); ++rep_) {
    if PH(5) { pg8::Gemm gm{WSP(bf16, WS_MIXED), WSP(bf16, WS_WUPA), S_, D_, PW, PW, PW}; pg8::StaticOrder so; so.init(S_, D_, G, bx); pg8::EpiGateMulBf16 E{WSP(bf16, WS_TMP), WSP(bf16, WS_RA)};
      pg8::gemm_phase<pg8::EpiGateMulBf16, pg8::StaticOrder, true, true>(lds, gm, so, E); }
    if PH(5) { pg8::Gemm gm{WSP(bf16, WS_MLAO), WSP(bf16, WS_WUPB), S_, D_, MLAW, MLAW, MLAW}; pg8::StaticOrder so; so.init(S_, D_, G, bx); pg8::EpiGateAddBf16 E{WSP(bf16, WS_RC), WSP(bf16, WS_TMP), WSP(bf16, WS_RA) + D_};
      pg8::gemm_phase<pg8::EpiGateAddBf16, pg8::StaticOrder, true, true>(lds, gm, so, E); }
    GRID_BAR();
    }

#pragma unroll 1
    for (int rep_ = 0; rep_ < NREP(6); ++rep_) {
    if PH(6) { pg8::Gemm gm{WSP(bf16, WS_RC), WSP(bf16, WS_WOUT), S_, D_, D_, D_, D_}; pg8::StaticOrder so; so.init(S_, D_, G, bx); pg8::EpiBf16Scale E{WSP(bf16, WS_RA), D_, nullptr, nullptr};
      pg8::gemm_phase<pg8::EpiBf16Scale, pg8::StaticOrder, true, true>(lds, gm, so, E); }
    GRID_BAR();
    }

#pragma unroll 1
    for (int rep_ = 0; rep_ < NREP(7); ++rep_) {
    if PH(7) { stage_gain(lds, 0, INP(4), tid); stage_gain(lds, 16384, INP(16), tid); __syncthreads();
      const bf16* RAF = WSP(bf16, WS_RA); const float* x = INP(0); float* out = OUTP; bf16* RC = WSP(bf16, WS_RC);
      for (int m = gw; m < S_; m += NGW) { asm volatile("" ::: "memory");   norm_row<true>(RAF + (size_t)m * D_, x + (size_t)m * D_, out + (size_t)m * D_, (const LAS float*)lds, (const LAS float*)(lds + 16384), RC + (size_t)m * D_, lane); } }
    GRID_BAR();
    }

#pragma unroll 1
    for (int rep_ = 0; rep_ < NREP(8); ++rep_) {
    if PH(8) { pg8::Gemm gm{WSP(bf16, WS_RC), WSP(bf16, WS_WF1), S_, NF1, D_, D_, D_}; pg8::StaticOrder so; so.init(S_, NF1, G, bx); pg8::EpiSwiGLU E{WSP(bf16, WS_ACT)};
      pg8::gemm_phase<pg8::EpiSwiGLU, pg8::StaticOrder, true, true>(lds, gm, so, E); }
    GRID_BAR();
    }

#pragma unroll 1
    for (int rep_ = 0; rep_ < NREP(9); ++rep_) {
    if PH(9) { pg8::Gemm gm{WSP(bf16, WS_ACT), WSP(bf16, WS_WF2), S_, D_, FF, FF, FF}; pg8::StaticOrder so; so.init(S_, D_, G, bx); pg8::EpiBf16Scale E{WSP(bf16, WS_RA), D_, nullptr, nullptr};
      pg8::gemm_phase<pg8::EpiBf16Scale, pg8::StaticOrder, true, true>(lds, gm, so, E); }
    GRID_BAR();
    }

#pragma unroll 1
    for (int rep_ = 0; rep_ < NREP(10); ++rep_) {
    if PH(10) { stage_gain(lds, 0, INP(17), tid); stage_gain(lds, 16384, INP(21), tid); __syncthreads();
      const bf16* RAF = WSP(bf16, WS_RA); float* out = OUTP; bf16* RC = WSP(bf16, WS_RC);
      for (int m = gw; m < S_; m += NGW) { asm volatile("" ::: "memory");   norm_row<true>(RAF + (size_t)m * D_, out + (size_t)m * D_, out + (size_t)m * D_, (const LAS float*)lds, (const LAS float*)(lds + 16384), RC + (size_t)m * D_, lane); } }
    GRID_BAR();
    }

#pragma unroll 1
    for (int rep_ = 0; rep_ < NREP(11); ++rep_) {
    if PH(11) { pg8::Gemm gm{WSP(bf16, WS_PBF), WSP(bf16, WS_WPP), S_, D_, PLE, PLE, PLE}; pg8::StaticOrder so; so.init(S_, D_, G, bx); pg8::EpiBf16Scale E{WSP(bf16, WS_TMP), D_, nullptr, nullptr};
      pg8::gemm_phase<pg8::EpiBf16Scale, pg8::StaticOrder, true, true>(lds, gm, so, E); }
    if PH(11) { pg8::Gemm gm{WSP(bf16, WS_RC), WSP(bf16, WS_WPG), S_, D_, D_, D_, D_}; pg8::StaticOrder so; so.init(S_, D_, G, bx); pg8::EpiPle E{WSP(bf16, WS_TMP)};
      pg8::gemm_phase<pg8::EpiPle, pg8::StaticOrder, true, true>(lds, gm, so, E); }
    GRID_BAR();
    }

    if PH(12) { stage_gain(lds, 0, INP(24), tid); __syncthreads();
      const bf16* TMP = WSP(bf16, WS_TMP); float* out = OUTP;
      for (int m = gw; m < S_; m += NGW) { asm volatile("" ::: "memory");   norm_row<false>(TMP + (size_t)m * D_, out + (size_t)m * D_, out + (size_t)m * D_, (const LAS float*)lds, nullptr, nullptr, lane); } }
#undef GRID_BAR
}

extern "C" void kernel_launch(void* const* d_in, const int* in_sizes, int n_in, void* d_out, int out_size, void* d_ws, size_t ws_size, hipStream_t stream) {
    static int grid = 0;
    if (grid == 0) {
        if (n_in != 25 || in_sizes[0] != S_ * D_ || out_size != S_ * D_ || ws_size < WS_END) { fprintf(stderr, "kernel_launch: shape/workspace mismatch (n_in %d, in0 %d, out %d, ws %zu, need %zu); nothing launched\n", n_in, n_in > 0 ? in_sizes[0] : -1, out_size, ws_size, (size_t)WS_END); grid = -1; return; }
        int dev = 0, cus = 0, per_cu = 0;
        if (hipGetDevice(&dev) != hipSuccess || hipDeviceGetAttribute(&cus, hipDeviceAttributeMultiprocessorCount, dev) != hipSuccess) { fprintf(stderr, "kernel_launch: device query failed\n"); grid = -1; return; }
        if (hipFuncSetAttribute((const void*)fwd_kernel, hipFuncAttributeMaxDynamicSharedMemorySize, LDS_BYTES) != hipSuccess) { fprintf(stderr, "kernel_launch: hipFuncSetAttribute failed\n"); grid = -1; return; }
        if (hipOccupancyMaxActiveBlocksPerMultiprocessor(&per_cu, (const void*)fwd_kernel, NWAVES * 64, LDS_BYTES) != hipSuccess || per_cu < 1) fprintf(stderr, "kernel_launch: note: occupancy query reports %d blocks per CU\n", per_cu);
        (void)hipGetLastError();
        grid = cus;
    }
    if (grid < 0) return;
    if (hipMemsetAsync((char*)d_ws + WS_CTL, 0, CTL_ZERO_BYTES, stream) != hipSuccess) { fprintf(stderr, "kernel_launch: memset failed\n"); return; }
    Args a{};
    for (int i = 0; i < 25; ++i) a.in[i] = (const float*)d_in[i];
    a.pos = (const int*)d_in[2]; a.out = (float*)d_out; a.ws = (unsigned char*)d_ws;
    hipLaunchKernelGGL(fwd_kernel, dim3(grid), dim3(NWAVES * 64), LDS_BYTES, stream, a);
    const hipError_t le = hipPeekAtLastError();
    if (le != hipSuccess) fprintf(stderr, "kernel_launch: launch failed: %s\n", hipGetErrorName(le));
}
```

```cpp
#include <hip/hip_runtime.h>
#ifndef SLOT_ZS
#define SLOT_ZS 172
#define SLOT_FS 86
#define SLOT_P3S 4
#endif
#include <cstdio>
#include <cstdint>

namespace pg8 {
#define PG8_LAS __attribute__((address_space(3)))
typedef unsigned short bf16_t;
typedef short bf16x8 __attribute__((ext_vector_type(8)));
typedef float f32x4 __attribute__((ext_vector_type(4)));
typedef unsigned u32x4 __attribute__((ext_vector_type(4)));
typedef unsigned u32x2 __attribute__((ext_vector_type(2)));
typedef int i32x4 __attribute__((ext_vector_type(4)));
constexpr int BM = 256, BK = 64, HALF = 128, HTB = HALF * BK * 2  , STAGE_BYTES = 8 * HTB, NXCD = 8, WGM = 8;

__host__ __device__ __forceinline__ int lds_byte(int r, int c) { const int st = (r >> 4) * 2 + (c >> 5), rr = r & 15, cc = c & 31, ob = rr * 64 + cc * 2; return st * 1024 + (ob ^ (((ob >> 9) & 1) << 5)); }
__host__ __device__ __forceinline__ void stage_rc(int b, int& R, int& C) { const int st = b / 1024, sb = b % 1024, swz = sb ^ (((sb >> 9) & 1) << 5); R = (st >> 1) * 16 + swz / 64; C = (st & 1) * 32 + (swz % 64) / 2; }
__host__ __device__ __forceinline__ int perm32(int rho) { const int n = rho >> 4, i = rho & 15; return 8 * (i >> 2) + 4 * n + (i & 3); }

struct Unit { int pm, pn; };
struct Gemm { const bf16_t* A; const bf16_t* Bt; int M, N, K, lda, ldb; };

struct StaticOrder {
    int nM, nN, nwg, G, c, stride, cnt;
    __host__ __device__ void init(int M, int N, int G_, int c_) { nM = M / BM; nN = N / BM; nwg = nM * nN; G = G_; c = c_; stride = G_; cnt = 0x7fffffff; }
    __host__ __device__ bool next(int i, Unit& u) const {
        const long L = (long)i * stride + c; if (i >= cnt || L >= nwg) return false;
        int wgid = (int)L; { const int q = nwg / NXCD, r = nwg % NXCD, xcd = wgid % NXCD, off = wgid / NXCD; wgid = (xcd < r ? xcd * (q + 1) : r * (q + 1) + (xcd - r) * q) + off; }
        const int nig = WGM * nN, gid = wgid / nig, fm = gid * WGM, gsz = (nM - fm) < WGM ? (nM - fm) : WGM;
        u.pm = fm + ((wgid % nig) % gsz); u.pn = (wgid % nig) / gsz; return true;
    }
    __device__ __forceinline__ void a_ready(const Unit&) const {}
    __device__ __forceinline__ void done(const Unit&) const {}
};

typedef __bf16 bf16x2_t __attribute__((ext_vector_type(2)));
typedef float f32x2_t __attribute__((ext_vector_type(2)));
__device__ __forceinline__ unsigned cvt_pk_bf16(float lo, float hi) { const f32x2_t v = {lo, hi}; const bf16x2_t b = __builtin_convertvector(v, bf16x2_t); return __builtin_bit_cast(unsigned, b); }
__device__ __forceinline__ float bf_lo(unsigned w) { return __uint_as_float(w << 16); }
__device__ __forceinline__ float bf_hi(unsigned w) { return __uint_as_float(w & 0xffff0000u); }
__device__ __forceinline__ float sigm(float v) { return __builtin_amdgcn_rcpf(1.0f + __builtin_amdgcn_exp2f(-1.4426950408889634f * v)); }
__device__ __forceinline__ float sigmt(float t) { return __builtin_amdgcn_rcpf(1.0f + __builtin_amdgcn_exp2f(t)); }
__device__ __forceinline__ f32x4 sigmt4(f32x4 t) { return (f32x4){sigmt(t[0]), sigmt(t[1]), sigmt(t[2]), sigmt(t[3])}; }
__device__ __forceinline__ f32x4 sigm4(f32x4 v) { return (f32x4){sigm(v[0]), sigm(v[1]), sigm(v[2]), sigm(v[3])}; }
__device__ __forceinline__ u32x4 pack8(f32x4 v0, f32x4 v1) { u32x4 w; w.x = cvt_pk_bf16(v0[0], v0[1]); w.y = cvt_pk_bf16(v0[2], v0[3]); w.z = cvt_pk_bf16(v1[0], v1[1]); w.w = cvt_pk_bf16(v1[2], v1[3]); return w; }

struct EpiF32 {
    static constexpr bool PERM = false, AFTER_DRAIN = false;
    float* C; int ldc;
    __device__ __forceinline__ void operator()(const f32x4 (&acc)[2][2][4][2], const Unit& u, int wr, int wc, int fr, int fq) const {
        const int row0 = u.pm * BM + wr * 64 + fr, col0 = u.pn * BM + wc * 32 + 4 * fq;
#pragma unroll
        for (int ai = 0; ai < 2; ++ai)
#pragma unroll
            for (int m = 0; m < 4; ++m) { float* rowp = C + (size_t)(row0 + ai * HALF + m * 16) * ldc + col0;
#pragma unroll
                for (int bj = 0; bj < 2; ++bj)
#pragma unroll
                    for (int n = 0; n < 2; ++n) *(f32x4*)(rowp + bj * HALF + n * 16) = acc[ai][bj][m][n]; }
    }
};
struct EpiZG {
    static constexpr bool PERM = true, AFTER_DRAIN = false;
    bf16_t* Z; bf16_t* G;
    __device__ __forceinline__ void operator()(const f32x4 (&acc)[2][2][4][2], const Unit& u, int wr, int wc, int fr, int fq) const {
        const int row0 = u.pm * BM + wr * 64 + fr; const bool isg = u.pn >= 15;
        const int ldc = isg ? 8192 : 3840; bf16_t* base = isg ? G : Z; const int col0 = (isg ? (u.pn - 15) : u.pn) * BM + wc * 32 + 8 * fq;
#pragma unroll
        for (int ai = 0; ai < 2; ++ai)
#pragma unroll
            for (int m = 0; m < 4; ++m) { bf16_t* rowp = base + (size_t)(row0 + ai * HALF + m * 16) * ldc + col0;
#pragma unroll
                for (int bj = 0; bj < 2; ++bj) { f32x4 v0 = acc[ai][bj][m][0], v1 = acc[ai][bj][m][1];
                    if (isg) { v0 = sigm4(v0); v1 = sigm4(v1); }
                    *(u32x4*)(rowp + bj * HALF) = pack8(v0, v1); } }
    }
};
struct EpiBf16Scale {
    static constexpr bool PERM = true, AFTER_DRAIN = false;
    bf16_t* O; int ldc; const float* colscale; const float* rowscale;
    __device__ __forceinline__ void operator()(const f32x4 (&acc)[2][2][4][2], const Unit& u, int wr, int wc, int fr, int fq) const {
        const int row0 = u.pm * BM + wr * 64 + fr, col0 = u.pn * BM + wc * 32 + 8 * fq;
        f32x4 cs[2][2];
#pragma unroll
        for (int bj = 0; bj < 2; ++bj)
#pragma unroll
            for (int n = 0; n < 2; ++n) cs[bj][n] = colscale ? *(const f32x4*)(colscale + col0 + bj * HALF + 4 * n) : (f32x4){1.f, 1.f, 1.f, 1.f};
        float rvs[2][4];
#pragma unroll
        for (int ai = 0; ai < 2; ++ai)
#pragma unroll
            for (int m = 0; m < 4; ++m) rvs[ai][m] = rowscale ? rowscale[row0 + ai * HALF + m * 16] : 1.f;
#pragma unroll
        for (int ai = 0; ai < 2; ++ai)
#pragma unroll
            for (int m = 0; m < 4; ++m) { const int r = row0 + ai * HALF + m * 16; const float rs = rvs[ai][m]; bf16_t* rowp = O + (size_t)r * ldc + col0;
#pragma unroll
                for (int bj = 0; bj < 2; ++bj) { const f32x4 v0 = acc[ai][bj][m][0] * cs[bj][0] * rs, v1 = acc[ai][bj][m][1] * cs[bj][1] * rs;
                    *(u32x4*)(rowp + bj * HALF) = pack8(v0, v1); } }
    }
};
struct EpiQ {
    static constexpr bool PERM = true, AFTER_DRAIN = false;
    bf16_t* O; const float* rstd; const float* cosT; const float* sinT;
    __device__ __forceinline__ void operator()(const f32x4 (&acc)[2][2][4][2], const Unit& u, int wr, int wc, int fr, int fq) const {
        const int row0 = u.pm * BM + wr * 64 + fr, col0 = u.pn * BM + wc * 32 + 8 * fq;
        bool rope[2]; int i0[2];
#pragma unroll
        for (int bj = 0; bj < 2; ++bj) { const int c = col0 + bj * HALF, dd = c % 192; rope[bj] = dd >= 128; i0[bj] = rope[bj] ? (dd - 128) >> 1 : 0; }
        float rvs[2][4];
#pragma unroll
        for (int ai = 0; ai < 2; ++ai)
#pragma unroll
            for (int m = 0; m < 4; ++m) rvs[ai][m] = rstd[row0 + ai * HALF + m * 16];
#pragma unroll
        for (int am = 0; am < 4; ++am) { const int ai = am >> 1;
            f32x4 csv[4][2], snv[4][2];
#pragma unroll
            for (int m = 2 * (am & 1); m < 2 * (am & 1) + 2; ++m)
#pragma unroll
                for (int bj = 0; bj < 2; ++bj) if (rope[bj]) { const int r = row0 + ai * HALF + m * 16; csv[m][bj] = *(const f32x4*)(cosT + (size_t)r * 32 + i0[bj]); snv[m][bj] = *(const f32x4*)(sinT + (size_t)r * 32 + i0[bj]); }
#pragma unroll
            for (int m = 2 * (am & 1); m < 2 * (am & 1) + 2; ++m) { const int r = row0 + ai * HALF + m * 16; const float rs = rvs[ai][m]; bf16_t* rowp = O + (size_t)r * 3072 + col0;
#pragma unroll
                for (int bj = 0; bj < 2; ++bj) { f32x4 v0 = acc[ai][bj][m][0] * rs, v1 = acc[ai][bj][m][1] * rs;
                    if (rope[bj]) { const f32x4 cs = csv[m][bj], sn = snv[m][bj];
                        const f32x4 a = v0, b = v1;
                        v0[0] = a[0] * cs[0] - a[1] * sn[0]; v0[1] = a[0] * sn[0] + a[1] * cs[0]; v0[2] = a[2] * cs[1] - a[3] * sn[1]; v0[3] = a[2] * sn[1] + a[3] * cs[1];
                        v1[0] = b[0] * cs[2] - b[1] * sn[2]; v1[1] = b[0] * sn[2] + b[1] * cs[2]; v1[2] = b[2] * cs[3] - b[3] * sn[3]; v1[3] = b[2] * sn[3] + b[3] * cs[3]; }
                    *(u32x4*)(rowp + bj * HALF) = pack8(v0, v1); } } }
    }
};
struct EpiGateMulBf16 {
    static constexpr bool PERM = true, AFTER_DRAIN = false;
    bf16_t* T; const bf16_t* Gt;
    __device__ __forceinline__ void operator()(const f32x4 (&acc)[2][2][4][2], const Unit& u, int wr, int wc, int fr, int fq) const {
        const int row0 = u.pm * BM + wr * 64 + fr, col0 = u.pn * BM + wc * 32 + 8 * fq;
#pragma unroll
        for (int ai = 0; ai < 2; ++ai) {
            u32x4 gv[4][2];
#pragma unroll
            for (int m = 0; m < 4; ++m)
#pragma unroll
                for (int bj = 0; bj < 2; ++bj) gv[m][bj] = *(const u32x4*)(Gt + (size_t)(row0 + ai * HALF + m * 16) * 8192 + col0 + bj * HALF);
#pragma unroll
            for (int m = 0; m < 4; ++m) { const int r = row0 + ai * HALF + m * 16; bf16_t* rowp = T + (size_t)r * 4096 + col0;
#pragma unroll
                for (int bj = 0; bj < 2; ++bj) { const u32x4 g = gv[m][bj];
                    const f32x4 g0 = {bf_lo(g.x), bf_hi(g.x), bf_lo(g.y), bf_hi(g.y)}, g1 = {bf_lo(g.z), bf_hi(g.z), bf_lo(g.w), bf_hi(g.w)};
                    *(u32x4*)(rowp + bj * HALF) = pack8(acc[ai][bj][m][0] * g0, acc[ai][bj][m][1] * g1); } } }
    }
};
struct EpiGateAddBf16 {
    static constexpr bool PERM = true, AFTER_DRAIN = false;
    bf16_t* O; const bf16_t* T; const bf16_t* Gt;
    __device__ __forceinline__ void operator()(const f32x4 (&acc)[2][2][4][2], const Unit& u, int wr, int wc, int fr, int fq) const {
        const int row0 = u.pm * BM + wr * 64 + fr, col0 = u.pn * BM + wc * 32 + 8 * fq;
#pragma unroll
        for (int ai = 0; ai < 2; ++ai) {
            u32x4 gv[4][2], tv[4][2];
#pragma unroll
            for (int m = 0; m < 4; ++m)
#pragma unroll
                for (int bj = 0; bj < 2; ++bj) { const int r = row0 + ai * HALF + m * 16; gv[m][bj] = *(const u32x4*)(Gt + (size_t)r * 8192 + col0 + bj * HALF); tv[m][bj] = *(const u32x4*)(T + (size_t)r * 4096 + col0 + bj * HALF); }
#pragma unroll
            for (int m = 0; m < 4; ++m) { const int r = row0 + ai * HALF + m * 16; bf16_t* rowp = O + (size_t)r * 4096 + col0;
#pragma unroll
                for (int bj = 0; bj < 2; ++bj) { const u32x4 g = gv[m][bj], t = tv[m][bj];
                    const f32x4 g0 = {bf_lo(g.x), bf_hi(g.x), bf_lo(g.y), bf_hi(g.y)}, g1 = {bf_lo(g.z), bf_hi(g.z), bf_lo(g.w), bf_hi(g.w)};
                    const f32x4 t0 = {bf_lo(t.x), bf_hi(t.x), bf_lo(t.y), bf_hi(t.y)}, t1 = {bf_lo(t.z), bf_hi(t.z), bf_lo(t.w), bf_hi(t.w)};
                    *(u32x4*)(rowp + bj * HALF) = pack8(t0 + acc[ai][bj][m][0] * g0, t1 + acc[ai][bj][m][1] * g1); } } }
    }
};
struct EpiSwiGLU {
    static constexpr bool PERM = true, AFTER_DRAIN = false;
    bf16_t* O;
    __device__ __forceinline__ void operator()(const f32x4 (&acc)[2][2][4][2], const Unit& u, int wr, int wc, int fr, int fq) const {
        const int row0 = u.pm * BM + wr * 64 + fr, col0 = u.pn * 128 + wc * 16 + 4 * fq;
#pragma unroll
        for (int ai = 0; ai < 2; ++ai)
#pragma unroll
            for (int m = 0; m < 4; ++m) { bf16_t* rowp = O + (size_t)(row0 + ai * HALF + m * 16) * 11008 + col0;
#pragma unroll
                for (int bj = 0; bj < 2; ++bj) { const f32x4 gt = acc[ai][bj][m][0], up = acc[ai][bj][m][1]; const f32x4 a = gt * sigm4(gt) * up;
                    u32x2 w; w.x = cvt_pk_bf16(a[0], a[1]); w.y = cvt_pk_bf16(a[2], a[3]); *(u32x2*)(rowp + bj * 64) = w; } }
    }
};
struct EpiPle {
    static constexpr bool PERM = true, AFTER_DRAIN = false;
    bf16_t* T;
    __device__ __forceinline__ void operator()(const f32x4 (&acc)[2][2][4][2], const Unit& u, int wr, int wc, int fr, int fq) const {
        const int row0 = u.pm * BM + wr * 64 + fr, col0 = u.pn * BM + wc * 32 + 8 * fq;
#pragma unroll
        for (int ai = 0; ai < 2; ++ai)
#pragma unroll
            for (int m = 0; m < 4; ++m) { bf16_t* rowp = T + (size_t)(row0 + ai * HALF + m * 16) * 4096 + col0;
#pragma unroll
                for (int bj = 0; bj < 2; ++bj) { const u32x4 t = *(const u32x4*)(rowp + bj * HALF);
                    const f32x4 t0 = {bf_lo(t.x), bf_hi(t.x), bf_lo(t.y), bf_hi(t.y)}, t1 = {bf_lo(t.z), bf_hi(t.z), bf_lo(t.w), bf_hi(t.w)};
                    *(u32x4*)(rowp + bj * HALF) = pack8(t0 * sigm4(acc[ai][bj][m][0]), t1 * sigm4(acc[ai][bj][m][1])); }
                asm volatile("" ::: "memory"); }
    }
};

__device__ __forceinline__ f32x4 i2f4(f32x4 a) { const i32x4 i = __builtin_bit_cast(i32x4, a); return (f32x4){(float)i[0], (float)i[1], (float)i[2], (float)i[3]}; }
struct EpiGate8 {
    static constexpr bool PERM = true, AFTER_DRAIN = false, TWICE = false;
    bf16_t* G; const float* rs; const float* cs;
    __device__ __forceinline__ void operator()(const f32x4 (&acc)[2][2][4][2], const Unit& u, int wr, int wc, int fr, int fq) const {
        const int row0 = u.pm * BM + wr * 64 + fr, col0 = u.pn * BM + wc * 32 + 8 * fq;
        f32x4 cv[2][2];
#pragma unroll
        for (int bj = 0; bj < 2; ++bj)
#pragma unroll
            for (int n = 0; n < 2; ++n) cv[bj][n] = *(const f32x4*)(cs + col0 + bj * HALF + 4 * n) * -1.4426950408889634f;
        float rvs[2][4];
#pragma unroll
        for (int ai = 0; ai < 2; ++ai)
#pragma unroll
            for (int m = 0; m < 4; ++m) rvs[ai][m] = rs[row0 + ai * HALF + m * 16];
#pragma unroll
        for (int ai = 0; ai < 2; ++ai)
#pragma unroll
            for (int m = 0; m < 4; ++m) { const int r = row0 + ai * HALF + m * 16; const float rv = rvs[ai][m]; bf16_t* rowp = G + (size_t)r * 8192 + col0;
#pragma unroll
                for (int bj = 0; bj < 2; ++bj) *(u32x4*)(rowp + bj * HALF) = pack8(sigmt4(i2f4(acc[ai][bj][m][0]) * cv[bj][0] * rv), sigmt4(i2f4(acc[ai][bj][m][1]) * cv[bj][1] * rv)); }
    }
};
struct EpiPle8 {
    static constexpr bool PERM = true, AFTER_DRAIN = false, TWICE = false;
    bf16_t* T; const float* rs; const float* cs;
    __device__ __forceinline__ void operator()(const f32x4 (&acc)[2][2][4][2], const Unit& u, int wr, int wc, int fr, int fq) const {
        const int row0 = u.pm * BM + wr * 64 + fr, col0 = u.pn * BM + wc * 32 + 8 * fq;
        f32x4 cv[2][2];
#pragma unroll
        for (int bj = 0; bj < 2; ++bj)
#pragma unroll
            for (int n = 0; n < 2; ++n) cv[bj][n] = *(const f32x4*)(cs + col0 + bj * HALF + 4 * n) * -1.4426950408889634f;
        float rvs[2][4];
#pragma unroll
        for (int ai = 0; ai < 2; ++ai)
#pragma unroll
            for (int m = 0; m < 4; ++m) rvs[ai][m] = rs[row0 + ai * HALF + m * 16];
#pragma unroll
        for (int ai = 0; ai < 2; ++ai) {
            u32x4 tv[4][2];
#pragma unroll
            for (int m = 0; m < 4; ++m)
#pragma unroll
                for (int bj = 0; bj < 2; ++bj) tv[m][bj] = *(const u32x4*)(T + (size_t)(row0 + ai * HALF + m * 16) * 4096 + col0 + bj * HALF);
#pragma unroll
            for (int m = 0; m < 4; ++m) { const int r = row0 + ai * HALF + m * 16; const float rv = rvs[ai][m]; bf16_t* rowp = T + (size_t)r * 4096 + col0;
#pragma unroll
                for (int bj = 0; bj < 2; ++bj) { const u32x4 t = tv[m][bj];
                    const f32x4 t0 = {bf_lo(t.x), bf_hi(t.x), bf_lo(t.y), bf_hi(t.y)}, t1 = {bf_lo(t.z), bf_hi(t.z), bf_lo(t.w), bf_hi(t.w)};
                    *(u32x4*)(rowp + bj * HALF) = pack8(t0 * sigmt4(i2f4(acc[ai][bj][m][0]) * cv[bj][0] * rv), t1 * sigmt4(i2f4(acc[ai][bj][m][1]) * cv[bj][1] * rv)); } }
            asm volatile("" ::: "memory"); }
    }
};

struct EpiSwiGLU8 {
    static constexpr bool PERM = true, AFTER_DRAIN = false, TWICE = false, B32 = true;
    bf16_t* O; const float* rs; const float* cs;
    __device__ __forceinline__ void operator()(const f32x4 (&acc)[2][2][4][2], const Unit& u, int wr, int wc, int fr, int fq) const {
        const int row0 = u.pm * BM + wr * 64 + fr, col0 = u.pn * 128 + wc * 16 + 4 * fq, c0 = u.pn * BM + wc * 32 + 8 * fq;
        f32x4 cv[2][2];
#pragma unroll
        for (int bj = 0; bj < 2; ++bj)
#pragma unroll
            for (int n = 0; n < 2; ++n) cv[bj][n] = *(const f32x4*)(cs + c0 + bj * HALF + 4 * n);
        float rvs[2][4];
#pragma unroll
        for (int ai = 0; ai < 2; ++ai)
#pragma unroll
            for (int m = 0; m < 4; ++m) rvs[ai][m] = rs[row0 + ai * HALF + m * 16];
#pragma unroll
        for (int ai = 0; ai < 2; ++ai)
#pragma unroll
            for (int m = 0; m < 4; ++m) { const int r = row0 + ai * HALF + m * 16; const float rv = rvs[ai][m]; bf16_t* rowp = O + (size_t)r * 11008 + col0;
#pragma unroll
                for (int bj = 0; bj < 2; ++bj) { const f32x4 gt = i2f4(acc[ai][bj][m][0]) * cv[bj][0] * rv, up = i2f4(acc[ai][bj][m][1]) * cv[bj][1] * rv; const f32x4 a = gt * sigm4(gt) * up;
                    u32x2 w; w.x = cvt_pk_bf16(a[0], a[1]); w.y = cvt_pk_bf16(a[2], a[3]); *(u32x2*)(rowp + bj * 64) = w; } }
    }
};

template <class T, class = void> struct b32_of { static constexpr bool v = false; };
template <class T> struct b32_of<T, decltype((void)T::B32)> { static constexpr bool v = T::B32; };
template <class Epi, class Sched, bool ALIGN_EPI = false, bool SP2 = false, int PADW = 0, bool I8 = false>
__device__ __forceinline__ void gemm_phase(PG8_LAS unsigned char* lds, const Gemm g, const Sched& S, const Epi& E) {
    int tz = threadIdx.x; asm volatile("" : "+v"(tz));
    const int tid = tz, wid = __builtin_amdgcn_readfirstlane(tid >> 6), lane = tid & 63, wr = wid >> 2, wc = wid & 3, fr = lane & 15, fq = lane >> 4;
    int Kl = g.K; asm volatile("" : "+s"(Kl));
    const int K = Kl, nt = K / BK;
    unsigned voffA[2], voffB[2];
#pragma unroll
    for (int i = 0; i < 2; ++i) { int R, C; stage_rc(tid * 16 + i * 8192, R, C); int Rb = Epi::PERM ? ((R & ~31) + perm32(R & 31)) : R;
        if constexpr (b32_of<Epi>::v) Rb = (Rb & ~63) | (((Rb >> 2) & 1) << 5) | (((Rb >> 3) & 7) << 2) | (Rb & 3);
        voffA[i] = (unsigned)(R * g.lda + C) * 2u; voffB[i] = (unsigned)(Rb * g.ldb + C) * 2u; }
    const size_t kstep = (size_t)(BK * 2);
    const size_t hstepA = (size_t)HALF * g.lda * 2, hstepB = (size_t)HALF * g.ldb * 2;
    const size_t tstepA = 2 * hstepA, tstepB = 2 * hstepB;
    const unsigned ldsw = (unsigned)wid * 1024u;
    const int aoff = lds_byte(wr * 64 + fr, fq * 8), boff = lds_byte(wc * 32 + fr, fq * 8);
#define PG8_SA(b, h) (((b) * 2 + (h)) * HTB)
#define PG8_SB(b, h) ((4 + (b) * 2 + (h)) * HTB)
#define PG8_STAGE(bufoff, gbase, voff) do { _Pragma("unroll") for (int _i = 0; _i < 2; ++_i) \
        __builtin_amdgcn_global_load_lds((const unsigned*)((const char*)(gbase) + (voff)[_i]), (PG8_LAS unsigned*)(lds + (bufoff) + ldsw + _i * 8192), 16, 0, 0); } while (0)
#define PG8_LDA(dst, b, h) do { _Pragma("unroll") for (int m = 0; m < 4; ++m) _Pragma("unroll") for (int k = 0; k < 2; ++k) dst[m][k] = *(const PG8_LAS bf16x8*)(lds + PG8_SA(b, h) + aoff + m * 2048 + k * 1024); } while (0)
#define PG8_LDB(dst, b, h) do { _Pragma("unroll") for (int n = 0; n < 2; ++n) _Pragma("unroll") for (int k = 0; k < 2; ++k) dst[n][k] = *(const PG8_LAS bf16x8*)(lds + PG8_SB(b, h) + boff + n * 2048 + k * 1024); } while (0)
#define PG8_MMA(ai, bj, At, Bt) do { __builtin_amdgcn_s_setprio(1); _Pragma("unroll") for (int m = 0; m < 4; ++m) _Pragma("unroll") for (int n = 0; n < 2; ++n) _Pragma("unroll") for (int k = 0; k < 2; ++k) \
        { if constexpr (I8) acc[ai][bj][m][n] = __builtin_bit_cast(f32x4, __builtin_amdgcn_mfma_i32_16x16x64_i8(__builtin_bit_cast(i32x4, Bt[n][k]), __builtin_bit_cast(i32x4, At[m][k]), __builtin_bit_cast(i32x4, acc[ai][bj][m][n]), 0, 0, 0)); \
          else acc[ai][bj][m][n] = __builtin_amdgcn_mfma_f32_16x16x32_bf16(Bt[n][k], At[m][k], acc[ai][bj][m][n], 0, 0, 0); } __builtin_amdgcn_s_setprio(0); } while (0)
#define PG8_WAIT_V(n) asm volatile("s_waitcnt vmcnt(" #n ")" ::: "memory")
#define PG8_WAIT_L(n) asm volatile("s_waitcnt lgkmcnt(" #n ")" ::: "memory")
#define PG8_BAR __builtin_amdgcn_s_barrier()
#define PG8_SCHED __builtin_amdgcn_sched_barrier(0)
    Unit cur, nxt; int ui = 0;
    if (!S.next(0, cur)) return;
    f32x4 acc[2][2][4][2];
#pragma unroll
    for (int a = 0; a < 2; ++a)
#pragma unroll
        for (int b = 0; b < 2; ++b)
#pragma unroll
            for (int m = 0; m < 4; ++m)
#pragma unroll
                for (int n = 0; n < 2; ++n) acc[a][b][m][n] = (f32x4){0.f, 0.f, 0.f, 0.f};
    bf16x8 At[4][2], B0[2][2], B1[2][2];
    const char* cA = (const char*)g.A + (size_t)cur.pm * tstepA; const char* cB = (const char*)g.Bt + (size_t)cur.pn * tstepB;
    S.a_ready(cur);
    if constexpr (SP2) {
        PG8_STAGE(PG8_SB(0, 0), cB, voffB); PG8_STAGE(PG8_SB(0, 1), cB + hstepB, voffB); PG8_STAGE(PG8_SA(0, 0), cA, voffA); PG8_STAGE(PG8_SA(0, 1), cA + hstepA, voffA);
        if (wr == 1) PG8_BAR;
        PG8_WAIT_V(2); PG8_BAR;
        PG8_STAGE(PG8_SB(1, 0), cB + kstep, voffB); PG8_STAGE(PG8_SA(1, 0), cA + kstep, voffA); PG8_STAGE(PG8_SB(1, 1), cB + hstepB + kstep, voffB);
        PG8_WAIT_V(6); PG8_BAR;
    } else {
        PG8_STAGE(PG8_SB(0, 0), cB, voffB); PG8_STAGE(PG8_SA(0, 0), cA, voffA); PG8_STAGE(PG8_SB(0, 1), cB + hstepB, voffB); PG8_STAGE(PG8_SA(0, 1), cA + hstepA, voffA);
        if (wr == 1) PG8_BAR;
        PG8_WAIT_V(4); PG8_BAR;
        PG8_STAGE(PG8_SB(1, 0), cB + kstep, voffB); PG8_STAGE(PG8_SA(1, 0), cA + kstep, voffA); PG8_STAGE(PG8_SB(1, 1), cB + hstepB + kstep, voffB);
        PG8_WAIT_V(6); PG8_BAR;
    }
    for (;;) {
        const bool has_next = S.next(ui + 1, nxt);
        const char* nA = has_next ? (const char*)g.A + (size_t)nxt.pm * tstepA : cA; const char* nB = has_next ? (const char*)g.Bt + (size_t)nxt.pn * tstepB : cB;
        asm volatile(".p2align 6\n\t.fill %0, 4, 0xBF800000" :: "i"(PADW));
        for (int t = 0; t < nt; t += 2) {
            const bool last = (t == nt - 2);
            const char* a1 = cA + (size_t)(t + 1) * kstep;
            const char* a2 = last ? nA : cA + (size_t)(t + 2) * kstep; const char* b2 = last ? nB : cB + (size_t)(t + 2) * kstep;
            const char* a3 = a2 + kstep; const char* b3 = b2 + kstep;
            if (last && has_next) S.a_ready(nxt);
            if constexpr (SP2) {
            PG8_LDB(B0, 0, 0); PG8_LDB(B1, 0, 1); PG8_SCHED; PG8_LDA(At, 0, 0); PG8_STAGE(PG8_SA(1, 1), a1 + hstepA, voffA);
            PG8_WAIT_V(8); PG8_WAIT_L(0); PG8_BAR; PG8_MMA(0, 0, At, B0); PG8_MMA(0, 1, At, B1); PG8_BAR; PG8_SCHED;
            PG8_LDA(At, 0, 1); PG8_STAGE(PG8_SB(0, 0), b2, voffB); PG8_STAGE(PG8_SB(0, 1), b2 + hstepB, voffB); PG8_STAGE(PG8_SA(0, 0), a2, voffA);
            PG8_WAIT_V(8); PG8_WAIT_L(0); PG8_BAR; PG8_MMA(1, 0, At, B0); PG8_MMA(1, 1, At, B1); PG8_BAR; PG8_SCHED;
            PG8_LDB(B0, 1, 0); PG8_LDB(B1, 1, 1); PG8_SCHED; PG8_LDA(At, 1, 0); PG8_STAGE(PG8_SA(0, 1), a2 + hstepA, voffA);
            PG8_WAIT_V(8); PG8_WAIT_L(0); PG8_BAR; PG8_MMA(0, 0, At, B0); PG8_MMA(0, 1, At, B1); PG8_BAR; PG8_SCHED;
            PG8_LDA(At, 1, 1); PG8_STAGE(PG8_SB(1, 0), b3, voffB); PG8_STAGE(PG8_SB(1, 1), b3 + hstepB, voffB); PG8_STAGE(PG8_SA(1, 0), a3, voffA);
            PG8_WAIT_V(8); PG8_WAIT_L(0); PG8_BAR; PG8_MMA(1, 0, At, B0); PG8_MMA(1, 1, At, B1); PG8_BAR; PG8_SCHED;
            } else {
            PG8_LDB(B0, 0, 0); PG8_SCHED; PG8_LDA(At, 0, 0); PG8_STAGE(PG8_SA(1, 1), a1 + hstepA, voffA);
            PG8_WAIT_L(8); PG8_BAR; PG8_WAIT_L(0); PG8_MMA(0, 0, At, B0); PG8_BAR; PG8_SCHED;
            PG8_LDB(B1, 0, 1); PG8_STAGE(PG8_SB(0, 0), b2, voffB);
            PG8_BAR; PG8_WAIT_L(0); PG8_MMA(0, 1, At, B1); PG8_BAR;
            PG8_LDA(At, 0, 1); PG8_STAGE(PG8_SA(0, 0), a2, voffA);
            PG8_BAR; PG8_WAIT_L(0); PG8_MMA(1, 0, At, B0); PG8_BAR; PG8_SCHED;
            PG8_STAGE(PG8_SB(0, 1), b2 + hstepB, voffB);
            PG8_WAIT_V(6); PG8_BAR; PG8_MMA(1, 1, At, B1); PG8_BAR;
            PG8_LDB(B0, 1, 0); PG8_SCHED; PG8_LDA(At, 1, 0); PG8_STAGE(PG8_SA(0, 1), a2 + hstepA, voffA);
            PG8_WAIT_L(8); PG8_BAR; PG8_WAIT_L(0); PG8_MMA(0, 0, At, B0); PG8_BAR; PG8_SCHED;
            PG8_LDB(B1, 1, 1); PG8_STAGE(PG8_SB(1, 0), b3, voffB);
            PG8_BAR; PG8_WAIT_L(0); PG8_MMA(0, 1, At, B1); PG8_BAR;
            PG8_LDA(At, 1, 1); PG8_STAGE(PG8_SA(1, 0), a3, voffA);
            PG8_BAR; PG8_WAIT_L(0); PG8_MMA(1, 0, At, B0); PG8_BAR; PG8_SCHED;
            PG8_STAGE(PG8_SB(1, 1), b3 + hstepB, voffB);
            PG8_WAIT_V(6); PG8_BAR; PG8_MMA(1, 1, At, B1); PG8_BAR;
            }
        }
        if constexpr (ALIGN_EPI) { if (wr == 0) PG8_BAR; }
        E(acc, cur, wr, wc, fr, fq); S.done(cur);
        if (!has_next) break;
        { bf16x8 zf = {0, 0, 0, 0, 0, 0, 0, 0}; asm volatile("" : "+v"(zf));
#pragma unroll
        for (int a = 0; a < 2; ++a)
#pragma unroll
            for (int b = 0; b < 2; ++b)
#pragma unroll
                for (int m = 0; m < 4; ++m)
#pragma unroll
                    for (int n = 0; n < 2; ++n) { asm volatile("" : "+v"(zf));
                        if constexpr (I8) acc[a][b][m][n] = __builtin_bit_cast(f32x4, __builtin_amdgcn_mfma_i32_16x16x64_i8(__builtin_bit_cast(i32x4, zf), __builtin_bit_cast(i32x4, zf), (i32x4){0, 0, 0, 0}, 0, 0, 0));
                        else acc[a][b][m][n] = __builtin_amdgcn_mfma_f32_16x16x32_bf16(zf, zf, (f32x4){0.f, 0.f, 0.f, 0.f}, 0, 0, 0); } }
        cur = nxt; cA = nA; cB = nB; ++ui;
        if constexpr (ALIGN_EPI) { if (wr == 1) PG8_BAR; }
    }
    PG8_WAIT_V(0);
    if constexpr (!ALIGN_EPI) { if (wr == 0) PG8_BAR; }
    PG8_BAR;
#undef PG8_SA
#undef PG8_SB
#undef PG8_STAGE
#undef PG8_LDA
#undef PG8_LDB
#undef PG8_MMA
#undef PG8_WAIT_V
#undef PG8_WAIT_L
#undef PG8_BAR
#undef PG8_SCHED
}
}

namespace att {
#define ATT_LAS __attribute__((address_space(3)))
typedef unsigned short bf16;
typedef short bf16x8 __attribute__((ext_vector_type(8)));
typedef short s16x4 __attribute__((ext_vector_type(4)));
typedef float f32x16 __attribute__((ext_vector_type(16)));
typedef float f32x4 __attribute__((ext_vector_type(4)));
typedef unsigned u32x4 __attribute__((ext_vector_type(4)));
constexpr float SCALE = 0.07216878364870322f;
constexpr float THR = 8.f;
constexpr int SHM_V = 16384, SHM_KN = 16384, SHM_KR = 8192, BUF = SHM_V + SHM_KN + SHM_KR, NBUF = 3;
constexpr int OFF_V = 0, OFF_KN = SHM_V, OFF_KR = SHM_V + SHM_KN, OFF_WS = NBUF * BUF, ATT_LDS_BYTES = OFF_WS + 8 * 256;
#define SBAR() __builtin_amdgcn_sched_barrier(0)
__device__ __forceinline__ int v_st(int k, int c) { const int kk = (k & ~0xC) | ((k & 4) << 1) | ((k & 8) >> 1); return ((kk >> 3) * 4 + (c >> 5)) * 512 + ((kk & 7) * 32 + (c & 31)) * 2; }
__device__ __forceinline__ int v_rd_base(int lane) { return ((lane & 3) << 3) | (((lane >> 2) & 3) << 6) | (((lane >> 4) & 1) << 5) | (((lane >> 5) & 1) << 8); }
constexpr int v_rd_off(int d0, int ks, int half) { return d0 * 512 + ks * 4096 + half * 2048; }
__device__ __forceinline__ int crow(int r, int hi) { return (r & 3) + 8 * (r >> 2) + 4 * hi; }
__device__ __forceinline__ unsigned cvtpk(float lo, float hi) { return pg8::cvt_pk_bf16(lo, hi); }

__device__ __forceinline__ void partialSM(f32x16& p0, f32x16& p1, float& m_reg, float& mn, float& alpha) {
    float pmax = p0[0];
#pragma unroll
    for (int r = 1; r < 16; ++r) pmax = fmaxf(pmax, p0[r]);
#pragma unroll
    for (int r = 0; r < 16; ++r) pmax = fmaxf(pmax, p1[r]);
    { auto rr = __builtin_amdgcn_permlane32_swap(__float_as_uint(pmax), __float_as_uint(pmax), false, false);
      pmax = fmaxf(__uint_as_float(rr[0]), __uint_as_float(rr[1])); }
    constexpr float C2 = 1.4426950408889634f * SCALE;
    if (__builtin_expect(__all((pmax - m_reg) * SCALE <= THR), 1)) { mn = m_reg; alpha = 1.f; }
    else { mn = fmaxf(m_reg, pmax); alpha = __builtin_amdgcn_exp2f((m_reg - mn) * C2); m_reg = mn; }
    const float mnL = -mn * C2;
#pragma unroll
    for (int r = 0; r < 16; ++r) p0[r] = fmaf(p0[r], C2, mnL);
#pragma unroll
    for (int r = 0; r < 16; ++r) p1[r] = fmaf(p1[r], C2, mnL);
#pragma unroll
    for (int r = 0; r < 16; ++r) p0[r] = __builtin_amdgcn_exp2f(p0[r]);
}
__device__ __forceinline__ void finishSM(f32x16& p0, f32x16& p1, float alpha, float& l_reg, bf16x8& pa0, bf16x8& pa1, bf16x8& pa2, bf16x8& pa3) {
#pragma unroll
    for (int r = 0; r < 16; ++r) p1[r] = __builtin_amdgcn_exp2f(p1[r]);
    float ps = 0;
#pragma unroll
    for (int r = 0; r < 16; ++r) ps += p0[r];
#pragma unroll
    for (int r = 0; r < 16; ++r) ps += p1[r];
    { auto rr = __builtin_amdgcn_permlane32_swap(__float_as_uint(ps), __float_as_uint(ps), false, false);
      ps = __uint_as_float(rr[0]) + __uint_as_float(rr[1]); }
    l_reg = l_reg * alpha + ps;
#define PK4(P, B_, OUT) do { unsigned a0 = cvtpk(P[B_+0], P[B_+1]), a1 = cvtpk(P[B_+2], P[B_+3]);                          \
        unsigned b0 = cvtpk(P[B_+4], P[B_+5]), b1 = cvtpk(P[B_+6], P[B_+7]);                                             \
        auto r0 = __builtin_amdgcn_permlane32_swap(a0, b0, false, false); auto r1 = __builtin_amdgcn_permlane32_swap(a1, b1, false, false); \
        u32x4 w = {r0[0], r1[0], r0[1], r1[1]}; OUT = *reinterpret_cast<bf16x8*>(&w); } while (0)
    PK4(p0, 0, pa0); PK4(p0, 8, pa1); PK4(p1, 0, pa2); PK4(p1, 8, pa3);
#undef PK4
}
__device__ __forceinline__ void qkt(f32x16& p0, f32x16& p1, ATT_LAS const char* buf, int r32, int hi, const bf16x8* qr) {
    p0 = f32x16{}; p1 = f32x16{};
    ATT_LAS const char* kn = buf + OFF_KN + r32 * 256; const int xn = (r32 & 15) << 4;
    ATT_LAS const char* kr = buf + OFF_KR + r32 * 128; const int xr = ((r32 >> 1) & 7) << 4;
#define QK_ADDR(s) ((s) < 8 ? kn + (((s) * 32 + hi * 16) ^ xn) : kr + ((((s) - 8) * 32 + hi * 16) ^ xr))
#define QK_LD(X, s0) do { _Pragma("unroll") for (int i_ = 0; i_ < 3; ++i_) { ATT_LAS const char* a_ = QK_ADDR((s0) + i_); X##a[i_] = *(ATT_LAS const bf16x8*)a_; \
        X##b[i_] = *(ATT_LAS const bf16x8*)(a_ + ((s0) + i_ < 8 ? 32 * 256 : 32 * 128)); } } while (0)
#define QK_MM(X, s0) do { _Pragma("unroll") for (int i_ = 0; i_ < 3; ++i_) { p0 = __builtin_amdgcn_mfma_f32_32x32x16_bf16(X##a[i_], qr[(s0) + i_], p0, 0, 0, 0); \
        p1 = __builtin_amdgcn_mfma_f32_32x32x16_bf16(X##b[i_], qr[(s0) + i_], p1, 0, 0, 0); } } while (0)
    bf16x8 Xa[3], Xb[3], Ya[3], Yb[3];
    QK_LD(X, 0); QK_LD(Y, 3); SBAR();
    QK_MM(X, 0); SBAR(); QK_LD(X, 6); SBAR();
    QK_MM(Y, 3); SBAR(); QK_LD(Y, 9); SBAR();
    QK_MM(X, 6); SBAR();
    QK_MM(Y, 9);
#undef QK_ADDR
#undef QK_LD
#undef QK_MM
}
__device__ __forceinline__ void pv_tile(f32x16* o, int vb, bf16x8 pa0, bf16x8 pa1, bf16x8 pa2, bf16x8 pa3) {
#define TRRD(dst, off) asm volatile("ds_read_b64_tr_b16 %0, %1 offset:%2" : "=&v"(dst) : "v"(vb), "i"(off) : "memory")
#define PV_LD(S, d0) do { constexpr int b_ = v_rd_off(d0, 0, 0); TRRD(S##l0, b_); TRRD(S##h0, b_ + 2048); TRRD(S##l1, b_ + 4096); TRRD(S##h1, b_ + 6144); \
        TRRD(S##l2, b_ + 8192); TRRD(S##h2, b_ + 10240); TRRD(S##l3, b_ + 12288); TRRD(S##h3, b_ + 14336); } while (0)
#define PV_MM(S, d0) do { \
        o[d0] = __builtin_amdgcn_mfma_f32_32x32x16_bf16(pa0, (bf16x8){S##l0[0], S##l0[1], S##l0[2], S##l0[3], S##h0[0], S##h0[1], S##h0[2], S##h0[3]}, o[d0], 0, 0, 0);   \
        o[d0] = __builtin_amdgcn_mfma_f32_32x32x16_bf16(pa1, (bf16x8){S##l1[0], S##l1[1], S##l1[2], S##l1[3], S##h1[0], S##h1[1], S##h1[2], S##h1[3]}, o[d0], 0, 0, 0);   \
        o[d0] = __builtin_amdgcn_mfma_f32_32x32x16_bf16(pa2, (bf16x8){S##l2[0], S##l2[1], S##l2[2], S##l2[3], S##h2[0], S##h2[1], S##h2[2], S##h2[3]}, o[d0], 0, 0, 0);   \
        o[d0] = __builtin_amdgcn_mfma_f32_32x32x16_bf16(pa3, (bf16x8){S##l3[0], S##l3[1], S##l3[2], S##l3[3], S##h3[0], S##h3[1], S##h3[2], S##h3[3]}, o[d0], 0, 0, 0); } while (0)
#define PV_W(n) do { asm volatile("s_waitcnt lgkmcnt(" #n ")" ::: "memory"); SBAR(); } while (0)
    s16x4 Al0, Al1, Al2, Al3, Ah0, Ah1, Ah2, Ah3, Bl0, Bl1, Bl2, Bl3, Bh0, Bh1, Bh2, Bh3;
    PV_LD(A, 0); PV_LD(B, 1); PV_W(8); PV_MM(A, 0); SBAR();
    PV_LD(A, 2); PV_W(8); PV_MM(B, 1); SBAR();
    PV_LD(B, 3); PV_W(8); PV_MM(A, 2); SBAR();
    PV_W(0); PV_MM(B, 3);
#undef PV_W
#undef PV_MM
#undef PV_LD
#undef TRRD
}
__device__ __forceinline__ void attn_unit(ATT_LAS char* lds, const bf16* Q, const bf16* KV, const bf16* KRP, bf16* O, int h, int qb) {
    int tz = threadIdx.x; asm volatile("" : "+v"(tz));
    const int tid = tz, wid = __builtin_amdgcn_readfirstlane(tid >> 6), lane = tid & 63, r32 = lane & 31, hi = lane >> 5;
    const int ntw = 4 * qb + (wid >> 1) + 1, NT = 4 * qb + 4;
    bf16x8 qr[12];
    { const bf16* qrow = Q + (size_t)(qb * 256 + wid * 32 + r32) * 3072 + h * 192;
#pragma unroll
      for (int d0 = 0; d0 < 8; ++d0) qr[d0] = *(const bf16x8*)(qrow + d0 * 16 + hi * 8);
#pragma unroll
      for (int d0 = 0; d0 < 4; ++d0) qr[8 + d0] = *(const bf16x8*)(qrow + 128 + d0 * 16 + hi * 8); }
    ATT_LAS float* ws = (ATT_LAS float*)(lds + OFF_WS) + wid * 64; ATT_LAS float* li_l = ws; ATT_LAS float* al_l = ws + 32;
    float m_reg = -1e30f, l_reg = 0.f; f32x16 o[4] = {};
    unsigned offKN[2], offV[2], offKR;
#pragma unroll
    for (int i = 0; i < 2; ++i) { const int p = (wid * 2 + i) * 64 + lane; const int row = p >> 4, j = (p & 15) ^ (row & 15); offKN[i] = (unsigned)(row * 4096 + j * 8) * 2u;
        const int sub = p >> 5, q = p & 31, kk = (sub >> 2) * 8 + (q >> 2), col = (sub & 3) * 32 + (q & 3) * 8, key = (kk & ~0xC) | ((kk & 4) << 1) | ((kk & 8) >> 1);
        offV[i] = (unsigned)(key * 4096 + 128 + col) * 2u; }
    { const int p = wid * 64 + lane, row = p >> 3, j = (p & 7) ^ ((row >> 1) & 7); offKR = (unsigned)(row * 64 + j * 8) * 2u; }
    const int vb0 = (int)(uintptr_t)(lds + OFF_V) + v_rd_base(lane);
    const char* kvh = (const char*)(KV + h * 256);
    const bool grpB = wid >= 4;
#define ATT_GLDS(g, l) __builtin_amdgcn_global_load_lds((const unsigned*)(g), (ATT_LAS unsigned*)(l), 16, 0, 0)
#define ATT_DMA(bo, t) do { const char* kb_ = kvh + (size_t)(t) * (64 * 4096 * 2); const char* rb_ = (const char*)KRP + (size_t)(t) * (64 * 64 * 2); ATT_LAS char* l_ = lds + (bo);  \
        ATT_GLDS(kb_ + offKN[0], l_ + OFF_KN + (wid * 2 + 0) * 1024); ATT_GLDS(kb_ + offKN[1], l_ + OFF_KN + (wid * 2 + 1) * 1024); \
        ATT_GLDS(kb_ + offV[0], l_ + OFF_V + (wid * 2 + 0) * 1024); ATT_GLDS(kb_ + offV[1], l_ + OFF_V + (wid * 2 + 1) * 1024);       \
        ATT_GLDS(rb_ + offKR, l_ + OFF_KR + wid * 1024); } while (0)
#define ATT_RESC(a) do { if (__any((a) < 1.f)) { if (hi == 0) al_l[r32] = (a); asm volatile("s_waitcnt lgkmcnt(0)" ::: "memory");              \
        _Pragma("unroll") for (int d_ = 0; d_ < 4; ++d_) _Pragma("unroll") for (int r = 0; r < 16; ++r) o[d_][r] *= al_l[crow(r, hi)]; } } while (0)
#define ATT_BAR() asm volatile("s_barrier" ::: "memory")
#define ATT_WAIT_BAR() asm volatile("s_waitcnt vmcnt(0)\n\ts_barrier" ::: "memory")
    ATT_DMA(0, 0); ATT_DMA(BUF, 1);
    asm volatile("s_waitcnt vmcnt(0)" ::: "memory");
    if (grpB) { __builtin_amdgcn_s_setprio(1); ATT_BAR(); }
    int bo = 0, bo2 = 2 * BUF;
    for (int t = 0; t < NT; ++t) {
        f32x16 p0, p1; float mn, alpha; bf16x8 pa0, pa1, pa2, pa3;
        ATT_BAR();
        if (t < ntw) { qkt(p0, p1, lds + bo, r32, hi, qr); partialSM(p0, p1, m_reg, mn, alpha); }
        ATT_WAIT_BAR();
        if (t + 2 < NT) ATT_DMA(bo2, t + 2);
        if (t < ntw) { ATT_RESC(alpha); finishSM(p0, p1, alpha, l_reg, pa0, pa1, pa2, pa3); SBAR(); pv_tile(o, vb0 + bo, pa0, pa1, pa2, pa3); }
        bo = (bo == 2 * BUF) ? 0 : bo + BUF; bo2 = (bo2 == 2 * BUF) ? 0 : bo2 + BUF;
    }
    if (!grpB) ATT_BAR();
    __builtin_amdgcn_s_setprio(0);
    if (hi == 0) li_l[r32] = l_reg; asm volatile("s_waitcnt lgkmcnt(0)" ::: "memory");
    bf16* Ow = O + (size_t)(qb * 256 + wid * 32) * 2048 + h * 128;
#pragma unroll
    for (int r = 0; r < 16; ++r) { const int orow = crow(r, hi); const float rl = __builtin_amdgcn_rcpf(li_l[orow]);
#pragma unroll
        for (int d0 = 0; d0 < 4; ++d0) { const float v = o[d0][r] * rl; const float vn = __int_as_float(__builtin_amdgcn_mov_dpp(__float_as_int(v), 0xB1, 0xF, 0xF, true));
            if ((r32 & 1) == 0) *(unsigned*)(Ow + (size_t)orow * 2048 + d0 * 32 + r32) = cvtpk(v, vn); } }
    __syncthreads();
#undef ATT_BAR
#undef ATT_WAIT_BAR
#undef ATT_GLDS
#undef ATT_DMA
#undef ATT_RESC
#undef ATT_STEP
}
#undef SBAR
}

constexpr int NWAVES = 8;
constexpr int S_ = 8192, D_ = 4096, NZ = 3840, INW = 3648, NGATE = 8192, N1 = NZ + NGATE, PW = 2048, QLAT = 1024, KVLAT = 512, KROPE = 64;
constexpr int O1 = 2048, O2 = 3072, O3 = 3584;
constexpr int NHEAD = 16, NQ = 3072, NKV = 4096, MLAW = 2048, FF = 11008, NF1 = 2 * FF, PLE = 256;
constexpr float EPS = 1e-6f;
constexpr size_t MiB = 1u << 20;
constexpr size_t WS_CTL = 0, CTL_ZERO_BYTES = 1 * MiB;
constexpr size_t WS_W1 = 2 * MiB, WS_WPOOL = 96 * MiB, WS_WQ = 98 * MiB, WS_WKV = 104 * MiB, WS_WUPA = 108 * MiB, WS_WUPB = 124 * MiB, WS_WOUT = 140 * MiB,
                 WS_WF1 = 172 * MiB, WS_WF2 = 344 * MiB, WS_WPG = 430 * MiB, WS_WPP = 462 * MiB;
constexpr size_t WS_RA = 464 * MiB;
constexpr size_t WS_Z = 592 * MiB;
constexpr size_t WS_X1B = 2 * MiB;
constexpr size_t WS_POOLED = 652 * MiB;
constexpr size_t WS_TMP = 592 * MiB;
constexpr size_t WS_RC = 720 * MiB;
constexpr size_t WS_Q = 784 * MiB, WS_KV = 832 * MiB, WS_MIXED = 896 * MiB, WS_MLAO = 928 * MiB;
constexpr size_t WS_ACT = 784 * MiB;
constexpr size_t WS_PBF = 960 * MiB, WS_COS = 964 * MiB, WS_SIN = 965 * MiB, WS_KROPE = 966 * MiB, WS_RSTD = 967 * MiB;
constexpr size_t WS_H8 = 684 * MiB;
constexpr size_t WS_WG8 = 784 * MiB;
constexpr size_t WS_WPG8 = 968 * MiB;
constexpr size_t WS_SC = 984 * MiB;
constexpr size_t SC_CSG = 0, SC_CSP = 32768, SC_RSH = 65536, SC_RS3 = 98304, SC_CSF = 131072  , SC_RS2 = 229376  , WS_END = 985 * MiB;
constexpr size_t WS_WF18 = 172 * MiB;
static_assert(WS_ACT + (size_t)S_ * FF * 2 <= WS_PBF && WS_W1 + (size_t)N1 * D_ * 2 <= WS_WPOOL && WS_WF1 + (size_t)NF1 * D_ * 2 <= WS_WF2 && WS_WF2 + (size_t)D_ * FF * 2 <= WS_WPG, "d_ws map");
constexpr int CW_BAR = 4096;
constexpr int RING_BYTES = 131072, LDSCTL_OFF = RING_BYTES, MISC_OFF = LDSCTL_OFF + 320, LDS_BYTES = 147456;
static_assert(att::ATT_LDS_BYTES <= RING_BYTES, "attention LDS");

#define GAS __attribute__((address_space(1)))
#define LAS __attribute__((address_space(3)))
typedef unsigned short bf16;
typedef unsigned v4u __attribute__((ext_vector_type(4)));
typedef unsigned v2u __attribute__((ext_vector_type(2)));
typedef float f32x4 __attribute__((ext_vector_type(4)));
typedef GAS unsigned gu32;
#define RLX_AGENT __ATOMIC_RELAXED, __HIP_MEMORY_SCOPE_AGENT
#define LDS_WAIT() asm volatile("s_waitcnt lgkmcnt(0)" ::: "memory")
__device__ __forceinline__ unsigned f2bf(float f) { unsigned u = __builtin_bit_cast(unsigned, f); return (u + 0x7fffu + ((u >> 16) & 1u)) >> 16; }
__device__ __forceinline__ unsigned pk2(float lo, float hi) { return f2bf(lo) | (f2bf(hi) << 16); }
__device__ __forceinline__ float bflo(unsigned w) { return __uint_as_float(w << 16); }
__device__ __forceinline__ float bfhi(unsigned w) { return __uint_as_float(w & 0xffff0000u); }

#define XB_TMO      128
#define XB_XCNT(j)  (256  + 64 * (j))
#define XB_XSUB(j)  (1280 + 64 * (j))
#define XB_XGEN(j)  (2304 + 64 * (j))
#define XB_TOP      3328
#define XB_TOPGEN   3392
#define XCD_BAR_WORDS 3456
#define XB_SPIN_CAP (1u << 18)
__device__ __forceinline__ unsigned xb_ld(unsigned* p)              { return __hip_atomic_load(p, __ATOMIC_RELAXED, __HIP_MEMORY_SCOPE_AGENT); }
__device__ __forceinline__ unsigned xb_add(unsigned* p, unsigned v) { return __hip_atomic_fetch_add(p, v, __ATOMIC_RELAXED, __HIP_MEMORY_SCOPE_AGENT); }
__device__ __forceinline__ unsigned xb_xcc_id() { return (unsigned)__builtin_amdgcn_s_getreg((3 << 11) | 20) & 0xFu; }
#define XB_SPIN(cond, bar) do { unsigned _sp = 0; while (cond) { __builtin_amdgcn_s_sleep(1); \
    if ((++_sp & 255u) == 0u) { if (xb_ld(&(bar)[XB_TMO])) break; if (_sp > XB_SPIN_CAP) { atomicAdd(&(bar)[XB_TMO], 1u); break; } } } } while (0)
struct XcdBarrier { unsigned* bar; unsigned x; volatile LAS unsigned* st; };
__device__ __forceinline__ XcdBarrier xcd_barrier_post(unsigned* bar, volatile LAS unsigned* st) {
    XcdBarrier b; b.bar = bar; b.x = xb_xcc_id(); b.st = st;
    if (threadIdx.x == 0) (void)xb_add(&bar[XB_XCNT(b.x)], 1u);
    return b;
}
__device__ __forceinline__ void xcd_barrier_complete(unsigned* bar, unsigned x, unsigned& nloc, unsigned& nx) {
    const unsigned G = gridDim.x * gridDim.y * gridDim.z;
    unsigned sum, cnt, mine, sp = 0u;
    for (;;) {
        sum = 0u; cnt = 0u; mine = 0u;
#pragma unroll
        for (unsigned j = 0; j < 16; ++j) { const unsigned c = xb_ld(&bar[XB_XCNT(j)]); sum += c; cnt += (c > 0u) ? 1u : 0u; mine = (j == x) ? c : mine; }
        if (sum == G) break;
        __builtin_amdgcn_s_sleep(1);
        if ((++sp & 255u) == 0u) { if (xb_ld(&bar[XB_TMO])) break; if (sp > XB_SPIN_CAP) { atomicAdd(&bar[XB_TMO], 1u); break; } }
    }
    nloc = mine > 0u ? mine : 1u; nx = cnt > 0u ? cnt : 1u;
}
__device__ __forceinline__ void xcd_barrier(const XcdBarrier& b) {
    asm volatile("s_waitcnt vmcnt(0)" ::: "memory");
    __syncthreads();
    if (threadIdx.x == 0) {
        unsigned* bar = b.bar;
        __builtin_amdgcn_s_waitcnt(0);
        unsigned nloc = b.st[0], nx = b.st[1];
        if (nloc == 0u) { xcd_barrier_complete(bar, b.x, nloc, nx); b.st[0] = nloc; b.st[1] = nx; }
        const unsigned old = xb_add(&bar[XB_XSUB(b.x)], 1u);
        const unsigned gen = old / nloc;
        if (old + 1u == (gen + 1u) * nloc) {
            __builtin_amdgcn_fence(__ATOMIC_RELEASE, "agent");
            asm volatile("s_waitcnt vmcnt(0)" ::: "memory");
            const unsigned og = xb_add(&bar[XB_TOP], 1u);
            const unsigned tg = og / nx;
            if (og + 1u == (tg + 1u) * nx) xb_add(&bar[XB_TOPGEN], 1u);
            else XB_SPIN(xb_ld(&bar[XB_TOPGEN]) == tg, bar);
            __builtin_amdgcn_fence(__ATOMIC_ACQUIRE, "agent");
            xb_add(&bar[XB_XGEN(b.x)], 1u);
            asm volatile("s_waitcnt vmcnt(0)" ::: "memory");
        } else {
            XB_SPIN(xb_ld(&bar[XB_XGEN(b.x)]) == gen, bar);
            __builtin_amdgcn_fence(__ATOMIC_ACQUIRE, "agent");
            asm volatile("s_waitcnt vmcnt(0)" ::: "memory");
        }
    }
    __syncthreads();
}

__device__ __forceinline__ float wave_sum(float v) {
#pragma unroll
    for (int o = 1; o < 64; o <<= 1) v += __shfl_xor(v, o);
    return v;
}
struct TDesc { const float* src; const float* kscale; bf16* drow; int ldw, k0, perm, K; };
__device__ __forceinline__ TDesc tp_resolve(const float* W, const float* W2, const float* kscale, bf16* WT, int K, int Nd, int ldw, int kind, int item, int lane) {
    const int nblk = Nd / 64, kb = item / nblk, nb = item - kb * nblk, k0 = 64 * kb, n0 = 64 * nb;
    const int r = lane >> 4, c4 = (lane & 15) * 4;
    TDesc d; const float* src;
    if (kind == 1) { const int n = n0 + c4, q = n >> 3, s = (n >> 2) & 1; src = (s ? W2 : W) + 4 * q; }
    else src = W + n0 + c4;
    d.src = src + (size_t)(k0 + 2 * r) * ldw; d.kscale = kscale; d.drow = WT + (size_t)(n0 + (lane >> 3)) * K + k0; d.K = K; d.ldw = ldw; d.k0 = k0; d.perm = (kind == 2 && (nb % 3) == 2) ? 1 : 0;
    return d;
}
__device__ __forceinline__ void tp_load(const TDesc& d, f32x4 (&v)[16]) {
#pragma unroll
    for (int i = 0; i < 16; ++i) v[i] = *(const GAS f32x4*)(d.src + (size_t)(8 * (i >> 1) + (i & 1)) * d.ldw);
}
__device__ __forceinline__ void tp_load_nt(const TDesc& d, f32x4 (&v)[16]) {
#pragma unroll
    for (int i = 0; i < 16; ++i) v[i] = __builtin_nontemporal_load((const GAS f32x4*)(d.src + (size_t)(8 * (i >> 1) + (i & 1)) * d.ldw));
}
__device__ __forceinline__ void tp_finish(const TDesc& d, f32x4 (&v)[16], LAS unsigned* scr, int lane) {
    const int r = lane >> 4, c4 = (lane & 15) * 4;
    if (d.kscale) {
#pragma unroll
        for (int i = 0; i < 16; ++i) v[i] = v[i] * d.kscale[d.k0 + 8 * (i >> 1) + 2 * r + (i & 1)];
    }
#pragma unroll
    for (int m = 0; m < 8; ++m) { const f32x4 a = v[2 * m], b = v[2 * m + 1]; v4u w; w.x = pg8::cvt_pk_bf16(a.x, b.x); w.y = pg8::cvt_pk_bf16(a.y, b.y); w.z = pg8::cvt_pk_bf16(a.z, b.z); w.w = pg8::cvt_pk_bf16(a.w, b.w);
        *(LAS v4u*)(scr + (4 * m + r) * 68 + c4) = w; }
    LDS_WAIT(); asm volatile("" ::: "memory");
    const int kc = lane & 7, nl = lane >> 3;
#pragma unroll
    for (int j = 0; j < 8; ++j) { const int n = nl + 8 * j, ncol = d.perm ? 32 * (n & 1) + (n >> 1) : n; const LAS unsigned* s = scr + (4 * kc) * 68 + ncol;
        v4u o; o.x = s[0]; o.y = s[68]; o.z = s[136]; o.w = s[204]; __builtin_nontemporal_store(o, (GAS v4u*)(d.drow + (size_t)(8 * j) * d.K + 8 * kc)); }
    LDS_WAIT(); asm volatile("" ::: "memory");
}

struct Args { const float* in[25]; const int* pos; float* out; unsigned char* ws; };
__device__ __forceinline__ unsigned long long karg_u64(int off) { auto kp = (const __attribute__((address_space(4))) unsigned char*)__builtin_amdgcn_kernarg_segment_ptr(); asm volatile("" : "+s"(kp));
    return *(const __attribute__((address_space(4))) unsigned long long*)(kp + off); }

#define ROWF_LD4(base, i, h) (*(const GAS f32x4*)((const GAS char*)(base) + ((i) >> 1) * 4096 + lo32 + ((i) & 1) * 2048 + (h) * 16))
#define ROWF_ST4(base, i, h) (*(GAS f32x4*)((GAS char*)(base) + ((i) >> 1) * 4096 + lo32 + ((i) & 1) * 2048 + (h) * 16))
#define ROWB_LD8(base, i) (*(const GAS v4u*)((const GAS char*)(base) + ((i) >> 2) * 4096 + lo16 + ((i) & 3) * 1024))
#define ROWB_ST8(base, i) (*(GAS v4u*)((GAS char*)(base) + ((i) >> 2) * 4096 + lo16 + ((i) & 3) * 1024))
#define GAIN_LD4(gl, i, h) (*(const LAS f32x4*)((const LAS char*)(gl) + (i) * 2048 + lo32 + (h) * 16))
__device__ __forceinline__ float sq4(f32x4 a) { return (a.x * a.x + a.y * a.y) + (a.z * a.z + a.w * a.w); }
__device__ __forceinline__ float wave_max(float v) {
#pragma unroll
    for (int o = 1; o < 64; o <<= 1) v = fmaxf(v, __shfl_xor(v, o));
    return v;
}
__device__ __forceinline__ float amax4(f32x4 a) { return fmaxf(fmaxf(fabsf(a.x), fabsf(a.y)), fmaxf(fabsf(a.z), fabsf(a.w))); }
__device__ __forceinline__ unsigned q4(f32x4 a) {
    const int q0 = __float2int_rn(a.x), q1 = __float2int_rn(a.y), q2 = __float2int_rn(a.z), q3 = __float2int_rn(a.w);
    return (unsigned)(q0 & 255) | ((unsigned)(q1 & 255) << 8) | ((unsigned)(q2 & 255) << 16) | ((unsigned)q3 << 24);
}
#define ROWQ_ST8(base, i) (*(GAS v2u*)((GAS char*)(base) + (i) * 512 + lo8))
template <int HN, bool XIB = false, bool XOB = false>
__device__ __forceinline__ void norm_row(const bf16* y, const float* xi, float* xo, const LAS float* g1, const LAS float* g2, bf16* hn, signed char* hq, float* rsc_out, int lane) {
    const unsigned lo32 = (unsigned)lane * 32u, lo16 = (unsigned)lane * 16u, lo8 = (unsigned)lane * 8u;
    f32x4 v[16]; float ss = 0.f;
    v4u xb[XIB ? 8 : 1]; f32x4 xf[XIB ? 1 : 16];
    if constexpr (XIB) {
#pragma unroll
        for (int i = 0; i < 8; ++i) xb[i] = ROWB_LD8((const bf16*)xi, i); }
    else {
#pragma unroll
        for (int i = 0; i < 8; ++i) { xf[2 * i] = ROWF_LD4(xi, i, 0); xf[2 * i + 1] = ROWF_LD4(xi, i, 1); } }
#pragma unroll
    for (int i = 0; i < 8; ++i) { const v4u c = ROWB_LD8(y, i); v[2 * i] = (f32x4){bflo(c.x), bfhi(c.x), bflo(c.y), bfhi(c.y)}; v[2 * i + 1] = (f32x4){bflo(c.z), bfhi(c.z), bflo(c.w), bfhi(c.w)};
        ss += sq4(v[2 * i]) + sq4(v[2 * i + 1]); }
    const float rstd = 1.0f / sqrtf(wave_sum(ss) * (1.0f / D_) + EPS);
    float s2 = 0.f;
#pragma unroll
    for (int i = 0; i < 8; ++i) {
        if constexpr (XIB) { const v4u c = xb[i]; const f32x4 x0 = {bflo(c.x), bfhi(c.x), bflo(c.y), bfhi(c.y)}, x1 = {bflo(c.z), bfhi(c.z), bflo(c.w), bfhi(c.w)};
            v[2 * i] = x0 + v[2 * i] * rstd * GAIN_LD4(g1, i, 0); v[2 * i + 1] = x1 + v[2 * i + 1] * rstd * GAIN_LD4(g1, i, 1); s2 += sq4(v[2 * i]) + sq4(v[2 * i + 1]); }
        else {
#pragma unroll
            for (int h = 0; h < 2; ++h) { const f32x4 xv = xf[2 * i + h], gv = GAIN_LD4(g1, i, h); v[2 * i + h] = xv + v[2 * i + h] * rstd * gv; s2 += sq4(v[2 * i + h]); } } }
#pragma unroll
    for (int i = 0; i < 8; ++i) {
        if constexpr (XOB) { const f32x4 a = v[2 * i], b = v[2 * i + 1]; v4u w; w.x = pk2(a.x, a.y); w.y = pk2(a.z, a.w); w.z = pk2(b.x, b.y); w.w = pk2(b.z, b.w); ROWB_ST8((bf16*)xo, i) = w; }
        else {
#pragma unroll
            for (int h = 0; h < 2; ++h) ROWF_ST4(xo, i, h) = v[2 * i + h]; } }
    if constexpr (HN == 1) {
        const float rstd2 = 1.0f / sqrtf(wave_sum(s2) * (1.0f / D_) + EPS);
#pragma unroll
        for (int i = 0; i < 8; ++i) { const f32x4 a = v[2 * i] * rstd2 * GAIN_LD4(g2, i, 0), b = v[2 * i + 1] * rstd2 * GAIN_LD4(g2, i, 1);
            v4u w; w.x = pk2(a.x, a.y); w.y = pk2(a.z, a.w); w.z = pk2(b.x, b.y); w.w = pk2(b.z, b.w); ROWB_ST8(hn, i) = w; }
    }
    if constexpr (HN == 2) {
        const float rstd2 = 1.0f / sqrtf(wave_sum(s2) * (1.0f / D_) + EPS); float mx = 0.f;
#pragma unroll
        for (int i = 0; i < 8; ++i)
#pragma unroll
            for (int h = 0; h < 2; ++h) { v[2 * i + h] = v[2 * i + h] * rstd2 * GAIN_LD4(g2, i, h); mx = fmaxf(mx, amax4(v[2 * i + h])); }
        mx = fmaxf(wave_max(mx), 1e-30f); const float qs = 127.0f / mx;
        if (lane == 0) *rsc_out = mx * (1.0f / 127.0f);
#pragma unroll
        for (int i = 0; i < 8; ++i) { v2u w; w.x = q4(v[2 * i] * qs); w.y = q4(v[2 * i + 1] * qs); ROWQ_ST8(hq, i) = w; }
    }
}
__device__ __forceinline__ void prenorm_row(const float* xrow, const LAS float* g, bf16* hn, signed char* hq, float* rsc_out, int lane) {
    const unsigned lo32 = (unsigned)lane * 32u, lo16 = (unsigned)lane * 16u, lo8 = (unsigned)lane * 8u;
    f32x4 v[16]; float ss = 0.f;
#pragma unroll
    for (int i = 0; i < 8; ++i)
#pragma unroll
        for (int h = 0; h < 2; ++h) { v[2 * i + h] = ROWF_LD4(xrow, i, h); ss += sq4(v[2 * i + h]); }
    const float rstd = 1.0f / sqrtf(wave_sum(ss) * (1.0f / D_) + EPS); float mx = 0.f;
#pragma unroll
    for (int i = 0; i < 8; ++i) { const f32x4 a = v[2 * i] * rstd * GAIN_LD4(g, i, 0), b = v[2 * i + 1] * rstd * GAIN_LD4(g, i, 1); v[2 * i] = a; v[2 * i + 1] = b; mx = fmaxf(mx, fmaxf(amax4(a), amax4(b)));
        v4u w; w.x = pk2(a.x, a.y); w.y = pk2(a.z, a.w); w.z = pk2(b.x, b.y); w.w = pk2(b.z, b.w); ROWB_ST8(hn, i) = w; }
    mx = fmaxf(wave_max(mx), 1e-30f); const float qs = 127.0f / mx;
    if (lane == 0) *rsc_out = mx * (1.0f / 127.0f);
#pragma unroll
    for (int i = 0; i < 8; ++i) { v2u w; w.x = q4(v[2 * i] * qs); w.y = q4(v[2 * i + 1] * qs); ROWQ_ST8(hq, i) = w; }
}
__device__ __forceinline__ void requant_row(const bf16* wrow, signed char* qrow, float* csc_out, int lane) {
    const unsigned lo16 = (unsigned)lane * 16u, lo8 = (unsigned)lane * 8u;
    f32x4 v[16]; float mx = 0.f;
#pragma unroll
    for (int i = 0; i < 8; ++i) { const v4u c = ROWB_LD8(wrow, i); v[2 * i] = (f32x4){bflo(c.x), bfhi(c.x), bflo(c.y), bfhi(c.y)}; v[2 * i + 1] = (f32x4){bflo(c.z), bfhi(c.z), bflo(c.w), bfhi(c.w)};
        mx = fmaxf(mx, fmaxf(amax4(v[2 * i]), amax4(v[2 * i + 1]))); }
    mx = fmaxf(wave_max(mx), 1e-30f); const float qs = 127.0f / mx;
    if (lane == 0) *csc_out = mx * (1.0f / 127.0f);
#pragma unroll
    for (int i = 0; i < 8; ++i) { v2u w; w.x = q4(v[2 * i] * qs); w.y = q4(v[2 * i + 1] * qs); ROWQ_ST8(qrow, i) = w; }
}
__device__ __forceinline__ void strip32(const float* srcu, int ldw, signed char* qdst, float* cslu, int cstride, LAS unsigned char* lds, LAS float* red, int wave, int par) {
    int tz = threadIdx.x; asm volatile("" : "+v"(tz));
    const int lane = tz & 63, cg = lane & 7, kr = lane >> 3;
    float* csl = cslu + cstride * cg;
    const unsigned voff = (unsigned)((512 * wave + 4 * kr) * ldw + 4 * cg) * 4u;
    const GAS char* pu = (const GAS char*)srcu;
    unsigned P[16][4][2]; f32x4 v[16]; f32x4 mx = {0.f, 0.f, 0.f, 0.f};
#pragma unroll
    for (int j = 0; j < 16; ++j) v[j] = __builtin_nontemporal_load((const GAS f32x4*)(pu + (size_t)((32 * (j >> 2) + (j & 3)) * ldw) * 4 + voff));
    asm volatile("" ::: "memory");
#pragma unroll
    for (int g = 0; g < 16; ++g) { const int b = (g & 3) * 4;
        const f32x4 a0 = v[b], a1 = v[b + 1], a2 = v[b + 2], a3 = v[b + 3];
#pragma unroll
        for (int c = 0; c < 4; ++c) { mx[c] = fmaxf(fmaxf(mx[c], fmaxf(fabsf(a0[c]), fabsf(a1[c]))), fmaxf(fabsf(a2[c]), fabsf(a3[c])));
            P[g][c][0] = pg8::cvt_pk_bf16(a0[c], a1[c]); P[g][c][1] = pg8::cvt_pk_bf16(a2[c], a3[c]);
            asm volatile("" : "+v"(P[g][c][0]), "+v"(P[g][c][1]), "+v"(mx[c])); }
        if (g + 4 < 16) {
#pragma unroll
            for (int t = 0; t < 4; ++t) v[b + t] = __builtin_nontemporal_load((const GAS f32x4*)(pu + (size_t)((32 * (g + 4) + t) * ldw) * 4 + voff));
            asm volatile("" ::: "memory"); } }
#pragma unroll
    for (int c = 0; c < 4; ++c) { float m = mx[c]; m = fmaxf(m, __shfl_xor(m, 8)); m = fmaxf(m, __shfl_xor(m, 16)); m = fmaxf(m, __shfl_xor(m, 32)); mx[c] = bflo(pg8::cvt_pk_bf16(m, m)); }
    LAS float* rp = red + par * 256;
    if (kr == 0) *(LAS f32x4*)(rp + wave * 32 + 4 * cg) = mx;
    __syncthreads();
    f32x4 m8 = *(const LAS f32x4*)(rp + 4 * cg);
#pragma unroll
    for (int w = 1; w < 8; ++w) { const f32x4 r = *(const LAS f32x4*)(rp + w * 32 + 4 * cg);
#pragma unroll
        for (int c = 0; c < 4; ++c) m8[c] = fmaxf(m8[c], r[c]); }
    f32x4 qs;
#pragma unroll
    for (int c = 0; c < 4; ++c) { m8[c] = fmaxf(m8[c], 1e-30f); qs[c] = 127.0f / m8[c]; }
    if (wave == 0 && kr == 0) *(GAS f32x4*)csl = m8 * (1.0f / 127.0f);
    LAS unsigned char* img = lds + wave * 16384;
    const unsigned wbase = (unsigned)(4 * cg) * 512u + 4u * (unsigned)kr, cgx = (unsigned)cg * 32u;
#pragma unroll
    for (int g = 0; g < 16; ++g) { const unsigned col = wbase + (((unsigned)g * 32u) ^ cgx);
#pragma unroll
        for (int c = 0; c < 4; ++c) { const unsigned lo = P[g][c][0], hi = P[g][c][1]; const float s = qs[c];
            const unsigned r0 = __float_as_uint(fmaf(bflo(lo), s, 12582912.0f)), r1 = __float_as_uint(fmaf(bfhi(lo), s, 12582912.0f)),
                           r2 = __float_as_uint(fmaf(bflo(hi), s, 12582912.0f)), r3 = __float_as_uint(fmaf(bfhi(hi), s, 12582912.0f));
            const unsigned t01 = __builtin_amdgcn_perm(r1, r0, 0x0c0c0400u), t23 = __builtin_amdgcn_perm(r3, r2, 0x0c0c0400u);
            *(LAS unsigned*)(img + col + c * 512) = __builtin_amdgcn_perm(t23, t01, 0x05040100u); } }
    const unsigned hi1 = (unsigned)lane >> 5, ch = (unsigned)lane & 31u;
    GAS unsigned char* qp = (GAS unsigned char*)qdst + (size_t)hi1 * D_ + 512u * (unsigned)wave + 16u * ch;
#pragma unroll
    for (int it = 0; it < 16; ++it) { const v4u w = *(const LAS v4u*)(img + (2 * it) * 512 + hi1 * 512u + 16u * (ch ^ (unsigned)(it & ~1)));
        __builtin_nontemporal_store(w, (GAS v4u*)(qp + (size_t)it * 2 * D_)); }
}
template <int W>
__device__ __forceinline__ void pool_load(const bf16* zp, int t, v4u (&c)[W]) {
    const int cnt = (t + 1 < W) ? t + 1 : W;
#pragma unroll
    for (int j = 0; j < W; ++j) { const int jj = j < cnt ? j : 0; c[j] = *(const GAS v4u*)(zp - (size_t)jj * NZ); }
}
template <int W>
__device__ __forceinline__ void pool_finish(const v4u (&c)[W], bf16* op, int t) {
    const int cnt = (t + 1 < W) ? t + 1 : W;
    float a[8];
    a[0] = bflo(c[0].x); a[1] = bfhi(c[0].x); a[2] = bflo(c[0].y); a[3] = bfhi(c[0].y); a[4] = bflo(c[0].z); a[5] = bfhi(c[0].z); a[6] = bflo(c[0].w); a[7] = bfhi(c[0].w);
    float u0[8];
#pragma unroll
    for (int e = 0; e < 8; ++e) u0[e] = a[e];
#pragma unroll
    for (int j = 1; j < W; ++j) { const float wj = j < cnt ? 1.0f : 0.0f;
        a[0] = fmaf(wj, bflo(c[j].x), a[0]); a[1] = fmaf(wj, bfhi(c[j].x), a[1]); a[2] = fmaf(wj, bflo(c[j].y), a[2]); a[3] = fmaf(wj, bfhi(c[j].y), a[3]);
        a[4] = fmaf(wj, bflo(c[j].z), a[4]); a[5] = fmaf(wj, bfhi(c[j].z), a[5]); a[6] = fmaf(wj, bflo(c[j].w), a[6]); a[7] = fmaf(wj, bfhi(c[j].w), a[7]); }
    const float ic = 1.0f / (float)cnt;
    v4u o; o.x = pk2(a[0] * ic - u0[0], a[1] * ic - u0[1]); o.y = pk2(a[2] * ic - u0[2], a[3] * ic - u0[3]); o.z = pk2(a[4] * ic - u0[4], a[5] * ic - u0[5]); o.w = pk2(a[6] * ic - u0[6], a[7] * ic - u0[7]);
    *(GAS v4u*)op = o;
}
template <int W>
__device__ __forceinline__ void pool_group(const bf16* Z, bf16* POOLED, int g, int gw, int NGW, int lane) {
    for (int t = gw; t < S_; t += 2 * NGW) { const int t2 = t + NGW; const bool two = t2 < S_;
        const bf16* zp = Z + (size_t)t * NZ + g * 512 + lane * 8; const bf16* zp2 = Z + (size_t)(two ? t2 : t) * NZ + g * 512 + lane * 8;
        v4u c1[W], c2[W];
        pool_load<W>(zp, t, c1); pool_load<W>(zp2, two ? t2 : t, c2);
        pool_finish<W>(c1, POOLED + (size_t)t * PW + g * 512 + lane * 8, t);
        if (two) pool_finish<W>(c2, POOLED + (size_t)t2 * PW + g * 512 + lane * 8, t2); }
}
__device__ __forceinline__ void stage_gain(LAS unsigned char* lds, int off, const float* g, int) {
    int tz = threadIdx.x; asm volatile("" : "+v"(tz));
    for (int i = tz; i < D_ / 4; i += NWAVES * 64) *(LAS f32x4*)(lds + off + i * 16) = *(const GAS f32x4*)(g + i * 4);
}

#ifndef GPAD0
#define GPAD0 8
#endif
#ifndef GPAD1
#define GPAD1 8
#endif
#ifndef GPAD2
#define GPAD2 13
#endif
#ifndef GPAD3
#define GPAD3 13
#endif
#ifndef GPAD4
#define GPAD4 8
#endif
#ifndef GPAD5
#define GPAD5 8
#endif
#ifndef GPAD6
#define GPAD6 8
#endif
#ifndef GPAD7
#define GPAD7 8
#endif
#ifndef GPAD8
#define GPAD8 2
#endif
#ifndef GPAD9
#define GPAD9 8
#endif
#ifndef GPAD10
#define GPAD10 8
#endif
#ifndef GPAD11
#define GPAD11 8
#endif
#ifndef PHASE_MASK
#define PHASE_MASK 0xFFFF
#endif
#define PH(k) constexpr ((PHASE_MASK >> (k)) & 1)
#ifndef REP_PHASE
#define REP_PHASE -1
#endif
#define NREP(k) (((k) == REP_PHASE) ? 2 : 1)
__global__ void __launch_bounds__(NWAVES * 64, 2) fwd_kernel(Args args) {
    extern __shared__ __attribute__((aligned(16))) unsigned char lds_raw[];
    LAS unsigned char* lds = (LAS unsigned char*)lds_raw;
    volatile LAS unsigned* MISC = (volatile LAS unsigned*)(lds + MISC_OFF);
    const int tid = threadIdx.x, lane = tid & 63, wave = __builtin_amdgcn_readfirstlane(tid >> 6);
    const int G = gridDim.x, bx = blockIdx.x;
    const int vcu = (G % 8 == 0) ? (bx % 8) * (G / 8) + bx / 8 : bx;
    const int gw = vcu * NWAVES + wave, NGW = G * NWAVES;
    (void)args;
#define INP(i) ((const float*)(const GAS float*)karg_u64(8 * (i)))
#define WSB ((unsigned char*)(GAS unsigned char*)karg_u64(216))
#define OUTP ((float*)(GAS float*)karg_u64(208))
    for (int u = tid; u < (LDS_BYTES - LDSCTL_OFF) / 4; u += NWAVES * 64) ((LAS unsigned*)(lds + LDSCTL_OFF))[u] = 0u;
    __syncthreads();
    XcdBarrier bar = xcd_barrier_post((unsigned*)(WSB + WS_CTL) + CW_BAR, MISC + 8);
#define GRID_BAR() xcd_barrier(bar)

#define WSP(T, off) ((T*)(WSB + (off)))
    constexpr int ZS = SLOT_ZS, FS = SLOT_FS;
    constexpr int P3ITEMS = 8192, P3STRIPS = SLOT_P3S;
    static_assert(32 * SLOT_ZS + 64 * SLOT_FS == (FF / 64) * (D_ / 64), "the tail slots take exactly the W_ffn_down items; the attention-phase converters the 8192 items after them");
    const int DEFER = (G == 256) ? 32 * ZS + 64 * FS + P3ITEMS : 0;
    const int NS3 = (G == 256) ? 16 * P3STRIPS : 0;
    constexpr int NS_G = NGATE / 32, NS_P = D_ / 32, NS_F = NF1 / 32, NSTRIPS = NS_G + NS_P + NS_F;
#define STRIP_DO(s_, par_) do { const float* src; signed char* Q8; float* csl; int ldw, cst, sl = (s_);                                                                             \
        if (sl < NS_G) { src = INP(14) + 32 * sl; Q8 = WSP(signed char, WS_WG8); csl = WSP(float, WS_SC + SC_CSG) + 32 * sl; ldw = NGATE; cst = 4; }                                 \
        else if ((sl -= NS_G) < NS_P) { src = INP(22) + 32 * sl; Q8 = WSP(signed char, WS_WPG8); csl = WSP(float, WS_SC + SC_CSP) + 32 * sl; ldw = D_; cst = 4; }                    \
        else { sl -= NS_P; src = ((sl & 1) ? INP(19) : INP(18)) + 32 * (sl >> 1); Q8 = WSP(signed char, WS_WF18); csl = WSP(float, WS_SC + SC_CSF) + 64 * (sl >> 1) + 4 * (sl & 1); ldw = FF; cst = 8; } \
        strip32(src, ldw, Q8 + (size_t)sl * 32 * D_, csl, cst, lds, (LAS float*)(lds + MISC_OFF + 4096), wave, (par_)); } while (0)
#define P3_RESOLVE(it_, d_, ln_) do { int r = (it_); if (r < 4096) d_ = tp_resolve(INP(15), nullptr, nullptr, WSP(bf16, WS_WOUT), D_, D_, D_, 0, r, ln_);                           \
        else if (r < 6144) d_ = tp_resolve(INP(12), nullptr, nullptr, WSP(bf16, WS_WUPA), PW, D_, D_, 0, r - 4096, ln_);                                                            \
        else d_ = tp_resolve(INP(13), nullptr, nullptr, WSP(bf16, WS_WUPB), MLAW, D_, D_, 0, r - 6144, ln_); } while (0)
#define P3_CONVERT(lo_, hi_) do { int tz_ = threadIdx.x; asm volatile("" : "+v"(tz_)); const int ln_ = tz_ & 63; LAS unsigned* scr_ = (LAS unsigned*)(lds + wave * 16384);          \
        TDesc d0, d1; f32x4 va[16], vb[16]; int it = (lo_) + wave; const int hi = (hi_);                                                                                            \
        if (it < hi) { P3_RESOLVE(it, d0, ln_); tp_load_nt(d0, va); }                                                                                                               \
        while (it < hi) { const int it1 = it + NWAVES, it2 = it1 + NWAVES; const bool h1 = it1 < hi, h2 = it2 < hi;                                                                  \
            if (h1) { P3_RESOLVE(it1, d1, ln_); tp_load_nt(d1, vb); }                                                                                                               \
            tp_finish(d0, va, scr_, ln_);                                                                                                                                           \
            if (h2) { P3_RESOLVE(it2, d0, ln_); tp_load_nt(d0, va); }                                                                                                               \
            if (h1) tp_finish(d1, vb, scr_, ln_);                                                                                                                                   \
            it = it2; } } while (0)
#define SLOT_CONVERT(lo_, hi_) do { int tz_ = threadIdx.x; asm volatile("" : "+v"(tz_)); const int ln_ = tz_ & 63; LAS unsigned* scr_ = (LAS unsigned*)(lds + wave * 16384);        \
        TDesc d0, d1; f32x4 va[16], vb[16]; int it = (lo_) + wave; const int hi = (hi_);                                                                                            \
        if (it < hi) { d0 = tp_resolve(INP(20), nullptr, nullptr, WSP(bf16, WS_WF2), FF, D_, D_, 0, it, ln_); tp_load_nt(d0, va); }                                                     \
        while (it < hi) { const int it1 = it + NWAVES, it2 = it1 + NWAVES; const bool h1 = it1 < hi, h2 = it2 < hi;                                                                  \
            if (h1) { d1 = tp_resolve(INP(20), nullptr, nullptr, WSP(bf16, WS_WF2), FF, D_, D_, 0, it1, ln_); tp_load_nt(d1, vb); }                                                    \
            tp_finish(d0, va, scr_, ln_);                                                                                                                                           \
            if (h2) { d0 = tp_resolve(INP(20), nullptr, nullptr, WSP(bf16, WS_WF2), FF, D_, D_, 0, it2, ln_); tp_load_nt(d0, va); }                                                    \
            if (h1) tp_finish(d1, vb, scr_, ln_);                                                                                                                                   \
            it = it2; } } while (0)
#pragma unroll 1
    for (int rep_ = 0; rep_ < NREP(0); ++rep_) {
    if PH(0) {
        { bf16* W1 = WSP(bf16, WS_W1); const int nchunk = (NZ - INW) * D_ / 8; for (int i = gw * 64 + lane; i < nchunk; i += NGW * 64) *(GAS v4u*)(W1 + (size_t)INW * D_ + (size_t)i * 8) = (v4u){0u, 0u, 0u, 0u}; }
        { stage_gain(lds, 0, INP(3), tid); __syncthreads();
          const float* x = INP(0); bf16* RC = WSP(bf16, WS_RC); signed char* H8 = WSP(signed char, WS_H8); float* RSH = WSP(float, WS_SC + SC_RSH);
          for (int m = gw; m < S_; m += NGW) { asm volatile("" ::: "memory"); prenorm_row(x + (size_t)m * D_, (const LAS float*)lds, RC + (size_t)m * D_, H8 + (size_t)m * D_, RSH + m, lane); } }
        { const float* p = INP(1); bf16* PBF = WSP(bf16, WS_PBF); const int nchunk = S_ * PLE / 8; for (int i = gw * 64 + lane; i < nchunk; i += NGW * 64) { const f32x4 a = *(const GAS f32x4*)(p + (size_t)i * 8), b = *(const GAS f32x4*)(p + (size_t)i * 8 + 4);
            v4u o; o.x = pk2(a.x, a.y); o.y = pk2(a.z, a.w); o.z = pk2(b.x, b.y); o.w = pk2(b.z, b.w); *(GAS v4u*)(PBF + (size_t)i * 8) = o; } }
        { const int* positions = (const int*)(const GAS int*)karg_u64(200); float* COST = WSP(float, WS_COS); float* SINT = WSP(float, WS_SIN);
        for (int i = gw * 64 + lane; i < S_ * 32; i += NGW * 64) { const int s = i >> 5, k = i & 31; const float inv = powf(10000.0f, -(float)(2 * k) / 64.0f); const float ang = (float)positions[s] * inv;
            COST[i] = cosf(ang); SINT[i] = sinf(ang); } }
        __syncthreads();
        LAS unsigned* scr = (LAS unsigned*)(lds + wave * 16384);
        constexpr int I_IN = (D_ / 64) * (INW / 64), I_POOL1 = (512 / 64) * (512 / 64), I_Q = (QLAT / 64) * (NQ / 64), I_KV = (KVLAT / 64) * (NKV / 64),
                      I_UP = (PW / 64) * (D_ / 64), I_OUT = (D_ / 64) * (D_ / 64), I_F2 = (FF / 64) * (D_ / 64), I_PP = (PLE / 64) * (D_ / 64);
        constexpr int NREG_ALL = I_IN + 4 * I_POOL1 + I_Q + I_KV + 2 * I_UP + I_OUT + I_F2 + I_PP;
        { int par = 0; const int NSTR0 = NSTRIPS - NS3;
#pragma unroll 1
          for (int s = bx; s < NSTR0; s += G, par ^= 1) STRIP_DO(s, par); }
#define TP_RESOLVE(it_, d_) do { int r = (it_); const float* W; const float* W2 = nullptr; const float* ks = nullptr; bf16* WT; int K, Nd, ldw, kind = 0;                    \
            if (r < I_F2) { W = INP(20); WT = WSP(bf16, WS_WF2); K = FF; Nd = D_; ldw = D_; }                                                                            \
            else if ((r -= I_F2) < I_OUT) { W = INP(15); WT = WSP(bf16, WS_WOUT); K = D_; Nd = D_; ldw = D_; }                                                           \
            else if ((r -= I_OUT) < I_UP) { W = INP(12); WT = WSP(bf16, WS_WUPA); K = PW; Nd = D_; ldw = D_; }                                                           \
            else if ((r -= I_UP) < I_UP) { W = INP(13); WT = WSP(bf16, WS_WUPB); K = MLAW; Nd = D_; ldw = D_; }                                                          \
            else if ((r -= I_UP) < I_Q) { W = INP(8); ks = INP(6); WT = WSP(bf16, WS_WQ); K = QLAT; Nd = NQ; ldw = NQ; kind = 2; }                                       \
            else if ((r -= I_Q) < I_KV) { W = INP(9); ks = INP(7); WT = WSP(bf16, WS_WKV); K = KVLAT; Nd = NKV; ldw = NKV; }                                             \
            else if ((r -= I_KV) < I_PP) { W = INP(23); WT = WSP(bf16, WS_WPP); K = PLE; Nd = D_; ldw = D_; }                                                            \
            else if ((r -= I_PP) < 4 * I_POOL1) { const int g = r / I_POOL1; r -= g * I_POOL1; W = INP(10) + (size_t)g * 512 * 512; WT = WSP(bf16, WS_WPOOL) + (size_t)g * 512 * 512; K = 512; Nd = 512; ldw = 512; } \
            else { r -= 4 * I_POOL1; W = INP(5); WT = WSP(bf16, WS_W1); K = D_; Nd = INW; ldw = INW; }                                                                   \
            d_ = tp_resolve(W, W2, ks, WT, K, Nd, ldw, kind, r, lane); } while (0)
        { constexpr int CSTRIP = 32;
          const int NREG = NREG_ALL - DEFER;
          const int NSTR0 = NSTRIPS - NS3; const int s_lo = NSTR0 / G, n_hi = NSTR0 % G;
          const int tavg = (NSTR0 * CSTRIP + NREG + G - 1) / G;
          int r_hi = tavg - CSTRIP * (s_lo + 1); r_hi = r_hi < 0 ? 0 : r_hi;
          const int r_lo = (G > n_hi) ? (NREG - n_hi * r_hi + (G - n_hi) - 1) / (G - n_hi) : 0;
          int lo = bx < n_hi ? bx * r_hi : n_hi * r_hi + (bx - n_hi) * r_lo, hi = lo + (bx < n_hi ? r_hi : r_lo);
          lo = lo > NREG ? NREG : lo; hi = hi > NREG ? NREG : hi;
          TDesc d0, d1; f32x4 va[16], vb[16]; int it = lo + wave;
          if (it < hi) { TP_RESOLVE(it + DEFER, d0); tp_load_nt(d0, va); }
          while (it < hi) {
              const int it1 = it + NWAVES, it2 = it1 + NWAVES; const bool h1 = it1 < hi, h2 = it2 < hi;
              if (h1) { TP_RESOLVE(it1 + DEFER, d1); tp_load_nt(d1, vb); }
              tp_finish(d0, va, scr, lane);
              if (h2) { TP_RESOLVE(it2 + DEFER, d0); tp_load_nt(d0, va); }
              if (h1) tp_finish(d1, vb, scr, lane);
              it = it2; } }
#undef TP_RESOLVE
    }
    GRID_BAR();
    }

#pragma unroll 1
    for (int rep_ = 0; rep_ < NREP(1); ++rep_) {
    if PH(1) {
        { pg8::Gemm g{WSP(bf16, WS_RC), WSP(bf16, WS_W1), S_, NZ, D_, D_, D_}; pg8::StaticOrder so; so.init(S_, NZ, G, bx); pg8::EpiBf16Scale E{WSP(bf16, WS_Z), NZ, nullptr, nullptr};
          pg8::gemm_phase<pg8::EpiBf16Scale, pg8::StaticOrder, true, true, GPAD0>(lds, g, so, E); }
        if (DEFER && bx >= 224) SLOT_CONVERT((bx - 224) * ZS, (bx - 223) * ZS); }
    GRID_BAR();
    }

#pragma unroll 1
    for (int rep_ = 0; rep_ < NREP(13); ++rep_) {
    if PH(1) {
      pg8::Gemm g{WSP(bf16, WS_H8), WSP(bf16, WS_WG8), S_, NGATE, D_ / 2, D_ / 2, D_ / 2}; pg8::StaticOrder so; so.init(S_, NGATE, G, bx);
      pg8::EpiGate8 E{WSP(bf16, WS_RA), WSP(float, WS_SC + SC_RSH), WSP(float, WS_SC + SC_CSG)};
      pg8::gemm_phase<pg8::EpiGate8, pg8::StaticOrder, true, true, GPAD11, true>(lds, g, so, E); }
    }

#pragma unroll 1
    for (int rep_ = 0; rep_ < NREP(2); ++rep_) {
    if PH(2) { int lz_ = threadIdx.x; asm volatile("" : "+v"(lz_)); const int lane = lz_ & 63; (void)lane;
        const bf16* Z = WSP(bf16, WS_Z); bf16* POOLED = WSP(bf16, WS_POOLED);
        pool_group<2>(Z, POOLED, 0, gw, NGW, lane); pool_group<4>(Z, POOLED, 1, gw, NGW, lane); pool_group<8>(Z, POOLED, 2, gw, NGW, lane); pool_group<16>(Z, POOLED, 3, gw, NGW, lane);
        float* RSTDQ = WSP(float, WS_RSTD); float* RSTDKV = RSTDQ + S_; const float* COST = WSP(float, WS_COS); const float* SINT = WSP(float, WS_SIN); bf16* KRP = WSP(bf16, WS_KROPE);
#define SQ8(c, acc_) do { float t_; t_ = bflo(c.x); acc_ += t_ * t_; t_ = bfhi(c.x); acc_ += t_ * t_; t_ = bflo(c.y); acc_ += t_ * t_; t_ = bfhi(c.y); acc_ += t_ * t_; \
                           t_ = bflo(c.z); acc_ += t_ * t_; t_ = bfhi(c.z); acc_ += t_ * t_; t_ = bflo(c.w); acc_ += t_ * t_; t_ = bfhi(c.w); acc_ += t_ * t_; } while (0)
        for (int m0 = gw; m0 < S_; m0 += 4 * NGW) {
            v4u q0[4], q1[4], k0[4]; float x1[4], x2[4], cs[4], sn[4];
#pragma unroll
            for (int j = 0; j < 4; ++j) { int m = m0 + j * NGW; m = m < S_ ? m : m0; const bf16* zr = Z + (size_t)m * NZ;
                q0[j] = *(const GAS v4u*)(zr + O1 + lane * 8); q1[j] = *(const GAS v4u*)(zr + O1 + 512 + lane * 8); k0[j] = *(const GAS v4u*)(zr + O2 + lane * 8);
                const int l32 = lane & 31;
                x1[j] = __uint_as_float((unsigned)zr[O3 + l32] << 16); x2[j] = __uint_as_float((unsigned)zr[O3 + 32 + l32] << 16); cs[j] = COST[m * 32 + l32]; sn[j] = SINT[m * 32 + l32]; }
#pragma unroll
            for (int j = 0; j < 4; ++j) { const int m = m0 + j * NGW; if (m < S_) {
                float sq = 0.f, sk = 0.f;
                SQ8(q0[j], sq); SQ8(q1[j], sq); SQ8(k0[j], sk);
                sq = wave_sum(sq); sk = wave_sum(sk);
                if (lane == 0) { RSTDQ[m] = 1.0f / sqrtf(sq * (1.0f / QLAT) + EPS); RSTDKV[m] = 1.0f / sqrtf(sk * (1.0f / KVLAT) + EPS); }
                if (lane < 32) *(GAS unsigned*)(KRP + (size_t)m * 64 + 2 * lane) = pk2(x1[j] * cs[j] - x2[j] * sn[j], x1[j] * sn[j] + x2[j] * cs[j]); } } }
#undef SQ8
    }
    GRID_BAR();
    }

#pragma unroll 1
    for (int rep_ = 0; rep_ < NREP(3); ++rep_) {
    if PH(3) {
#pragma unroll 1
        for (int g = 0; g < 4; ++g) { pg8::Gemm gm{WSP(bf16, WS_POOLED) + g * 512, WSP(bf16, WS_WPOOL) + (size_t)g * 512 * 512, S_, 512, 512, PW, 512}; pg8::StaticOrder so; so.init(S_, 512, G, (bx + 64 * g) % G);
            pg8::EpiBf16Scale E{WSP(bf16, WS_MIXED) + g * 512, PW, INP(11) + g * 512, nullptr};
            pg8::gemm_phase<pg8::EpiBf16Scale, pg8::StaticOrder, true, true, GPAD1>(lds, gm, so, E); }
        { pg8::Gemm gm{WSP(bf16, WS_Z) + O1, WSP(bf16, WS_WQ), S_, NQ, QLAT, NZ, QLAT}; pg8::StaticOrder so; so.init(S_, NQ, G, bx); pg8::EpiQ E{WSP(bf16, WS_Q), WSP(float, WS_RSTD), WSP(float, WS_COS), WSP(float, WS_SIN)};
          pg8::gemm_phase<pg8::EpiQ, pg8::StaticOrder, true, true, GPAD2>(lds, gm, so, E); }
        { pg8::Gemm gm{WSP(bf16, WS_Z) + O2, WSP(bf16, WS_WKV), S_, NKV, KVLAT, NZ, KVLAT}; pg8::StaticOrder so; so.init(S_, NKV, G, bx);
          if (G == 256) { so.stride = 128; so.cnt = bx < 128 ? 1 : 3; }
          pg8::EpiBf16Scale E{WSP(bf16, WS_KV), NKV, nullptr, WSP(float, WS_RSTD) + S_};
          pg8::gemm_phase<pg8::EpiBf16Scale, pg8::StaticOrder, true, true, GPAD3>(lds, gm, so, E); }
    }
    GRID_BAR();
    }

#pragma unroll 1
    for (int rep_ = 0; rep_ < NREP(4); ++rep_) {
    if PH(4) { const bf16* QB = WSP(bf16, WS_Q); const bf16* KVB = WSP(bf16, WS_KV); const bf16* KRP = WSP(bf16, WS_KROPE); bf16* MLAO = WSP(bf16, WS_MLAO);
      if (G == 256) { const int x = bx & 7, j = bx >> 3;
        if (j < 30) { const int h = x + 8 * (j / 15), a = 3 + j % 15;
#pragma unroll 1
          for (int half = 0; half < 2; ++half) att::attn_unit((ATT_LAS char*)lds, QB, KVB, KRP, MLAO, h, half == 0 ? 34 - a : a - 1); }
        else { const int h = x + 8 * (j - 30), ci = 2 * x + (j - 30);
#pragma unroll 1
          for (int half = 0; half < 2; ++half) att::attn_unit((ATT_LAS char*)lds, QB, KVB, KRP, MLAO, h, 1 - half);
          P3_CONVERT(ci * (P3ITEMS / 16), (ci + 1) * (P3ITEMS / 16));
          { const int tI = (FF / 64) * (D_ / 64); (void)tI; }
#pragma unroll 1
          for (int k = 0; k < P3STRIPS; ++k) STRIP_DO(NSTRIPS - NS3 + ci * P3STRIPS + k, k & 1); } }
      else
      for (int pr = bx; pr < 256; pr += G) { const int j = pr >> 3, h = (pr & 7) + 8 * (j >> 4), ql = j & 15;
#pragma unroll 1
        for (int half = 0; half < 2; ++half) att::attn_unit((ATT_LAS char*)lds, QB, KVB, KRP, MLAO, h, half == 0 ? 31 - ql : ql); } }
    GRID_BAR();
    }

#pragma unroll 1
    for (int rep_ = 0; rep_ < NREP(5); ++rep_) {
    if PH(5) { pg8::Gemm gm{WSP(bf16, WS_MIXED), WSP(bf16, WS_WUPA), S_, D_, PW, PW, PW}; pg8::StaticOrder so; so.init(S_, D_, G, bx); pg8::EpiGateMulBf16 E{WSP(bf16, WS_TMP), WSP(bf16, WS_RA)};
      pg8::gemm_phase<pg8::EpiGateMulBf16, pg8::StaticOrder, true, true, GPAD4>(lds, gm, so, E); }
    if PH(5) { pg8::Gemm gm{WSP(bf16, WS_MLAO), WSP(bf16, WS_WUPB), S_, D_, MLAW, MLAW, MLAW}; pg8::StaticOrder so; so.init(S_, D_, G, bx); pg8::EpiGateAddBf16 E{WSP(bf16, WS_RC), WSP(bf16, WS_TMP), WSP(bf16, WS_RA) + D_};
      pg8::gemm_phase<pg8::EpiGateAddBf16, pg8::StaticOrder, true, true, GPAD5>(lds, gm, so, E); }
    GRID_BAR();
    }

#pragma unroll 1
    for (int rep_ = 0; rep_ < NREP(6); ++rep_) {
    if PH(6) { pg8::Gemm gm{WSP(bf16, WS_RC), WSP(bf16, WS_WOUT), S_, D_, D_, D_, D_}; pg8::StaticOrder so; so.init(S_, D_, G, bx); pg8::EpiBf16Scale E{WSP(bf16, WS_RA), D_, nullptr, nullptr};
      pg8::gemm_phase<pg8::EpiBf16Scale, pg8::StaticOrder, true, true, GPAD6>(lds, gm, so, E); }
    GRID_BAR();
    }

#pragma unroll 1
    for (int rep_ = 0; rep_ < NREP(7); ++rep_) {
    if PH(7) { int lz_ = threadIdx.x; asm volatile("" : "+v"(lz_)); const int lane = lz_ & 63; (void)lane;     stage_gain(lds, 0, INP(4), tid); stage_gain(lds, 16384, INP(16), tid); __syncthreads();
      const bf16* RAF = WSP(bf16, WS_RA); const float* x = INP(0); float* out = OUTP; bf16* RC = WSP(bf16, WS_RC); float* RS2 = WSP(float, WS_SC + SC_RS2);
      bf16* X1B = WSP(bf16, WS_X1B); for (int m = gw; m < S_; m += NGW) { asm volatile("" ::: "memory");   norm_row<2, false, true>(RAF + (size_t)m * D_, x + (size_t)m * D_, (float*)(X1B + (size_t)m * D_), (const LAS float*)lds, (const LAS float*)(lds + 16384), nullptr, (signed char*)RC + (size_t)m * D_, RS2 + m, lane); } }
    GRID_BAR();
    }

#pragma unroll 1
    for (int rep_ = 0; rep_ < NREP(8); ++rep_) {
    if PH(8) { pg8::Gemm gm{WSP(bf16, WS_RC), WSP(bf16, WS_WF18), S_, NF1, D_ / 2, D_ / 2, D_ / 2}; pg8::StaticOrder so; so.init(S_, NF1, G, bx);
      pg8::EpiSwiGLU8 E{WSP(bf16, WS_ACT), WSP(float, WS_SC + SC_RS2), WSP(float, WS_SC + SC_CSF)};
      pg8::gemm_phase<pg8::EpiSwiGLU8, pg8::StaticOrder, true, true, GPAD7, true>(lds, gm, so, E);
      if (DEFER && bx >= 192) SLOT_CONVERT(32 * ZS + (bx - 192) * FS, 32 * ZS + (bx - 191) * FS); }
    GRID_BAR();
    }

#pragma unroll 1
    for (int rep_ = 0; rep_ < NREP(9); ++rep_) {
    if PH(9) { pg8::Gemm gm{WSP(bf16, WS_ACT), WSP(bf16, WS_WF2), S_, D_, FF, FF, FF}; pg8::StaticOrder so; so.init(S_, D_, G, bx); pg8::EpiBf16Scale E{WSP(bf16, WS_RA), D_, nullptr, nullptr};
      pg8::gemm_phase<pg8::EpiBf16Scale, pg8::StaticOrder, true, true, GPAD8>(lds, gm, so, E); }
    GRID_BAR();
    }

#pragma unroll 1
    for (int rep_ = 0; rep_ < NREP(10); ++rep_) {
    if PH(10) { int lz_ = threadIdx.x; asm volatile("" : "+v"(lz_)); const int lane = lz_ & 63; (void)lane;     stage_gain(lds, 0, INP(17), tid); stage_gain(lds, 16384, INP(21), tid); __syncthreads();
      const bf16* RAF = WSP(bf16, WS_RA); float* out = OUTP; signed char* H3Q = WSP(signed char, WS_RC); float* RS3 = WSP(float, WS_SC + SC_RS3);
      bf16* X1B = WSP(bf16, WS_X1B); for (int m = gw; m < S_; m += NGW) { asm volatile("" ::: "memory");   norm_row<2, true, true>(RAF + (size_t)m * D_, (const float*)(X1B + (size_t)m * D_), (float*)(X1B + (size_t)m * D_), (const LAS float*)lds, (const LAS float*)(lds + 16384), nullptr, H3Q + (size_t)m * D_, RS3 + m, lane); } }
    GRID_BAR();
    }

#pragma unroll 1
    for (int rep_ = 0; rep_ < NREP(11); ++rep_) {
    if PH(11) { pg8::Gemm gm{WSP(bf16, WS_PBF), WSP(bf16, WS_WPP), S_, D_, PLE, PLE, PLE}; pg8::StaticOrder so; so.init(S_, D_, G, bx); pg8::EpiBf16Scale E{WSP(bf16, WS_TMP), D_, nullptr, nullptr};
      pg8::gemm_phase<pg8::EpiBf16Scale, pg8::StaticOrder, true, true, GPAD9>(lds, gm, so, E); }
    if PH(11) { pg8::Gemm gm{WSP(bf16, WS_RC), WSP(bf16, WS_WPG8), S_, D_, D_ / 2, D_ / 2, D_ / 2}; pg8::StaticOrder so; so.init(S_, D_, G, bx);
      pg8::EpiPle8 E{WSP(bf16, WS_TMP), WSP(float, WS_SC + SC_RS3), WSP(float, WS_SC + SC_CSP)};
      pg8::gemm_phase<pg8::EpiPle8, pg8::StaticOrder, true, true, GPAD10, true>(lds, gm, so, E); }
    GRID_BAR();
    }

    if PH(12) { int lz_ = threadIdx.x; asm volatile("" : "+v"(lz_)); const int lane = lz_ & 63; (void)lane;     stage_gain(lds, 0, INP(24), tid); __syncthreads();
      const bf16* TMP = WSP(bf16, WS_TMP); float* out = OUTP;
      bf16* X1B = WSP(bf16, WS_X1B); for (int m = gw; m < S_; m += NGW) { asm volatile("" ::: "memory");   norm_row<0, true, false>(TMP + (size_t)m * D_, (const float*)(X1B + (size_t)m * D_), out + (size_t)m * D_, (const LAS float*)lds, nullptr, nullptr, nullptr, nullptr, lane); } }
#undef GRID_BAR
}

extern "C" void kernel_launch(void* const* d_in, const int* in_sizes, int n_in, void* d_out, int out_size, void* d_ws, size_t ws_size, hipStream_t stream) {
    static int grid = 0;
    if (grid == 0) {
        if (n_in != 25 || in_sizes[0] != S_ * D_ || out_size != S_ * D_ || ws_size < WS_END) { fprintf(stderr, "kernel_launch: shape/workspace mismatch (n_in %d, in0 %d, out %d, ws %zu, need %zu); nothing launched\n", n_in, n_in > 0 ? in_sizes[0] : -1, out_size, ws_size, (size_t)WS_END); grid = -1; return; }
        int dev = 0, cus = 0, per_cu = 0;
        if (hipGetDevice(&dev) != hipSuccess || hipDeviceGetAttribute(&cus, hipDeviceAttributeMultiprocessorCount, dev) != hipSuccess) { fprintf(stderr, "kernel_launch: device query failed\n"); grid = -1; return; }
        if (hipFuncSetAttribute((const void*)fwd_kernel, hipFuncAttributeMaxDynamicSharedMemorySize, LDS_BYTES) != hipSuccess) { fprintf(stderr, "kernel_launch: hipFuncSetAttribute failed\n"); grid = -1; return; }
        if (hipOccupancyMaxActiveBlocksPerMultiprocessor(&per_cu, (const void*)fwd_kernel, NWAVES * 64, LDS_BYTES) != hipSuccess || per_cu < 1) fprintf(stderr, "kernel_launch: note: occupancy query reports %d blocks per CU\n", per_cu);
        (void)hipGetLastError();
        grid = cus;
    }
    if (grid < 0) return;
    if (hipMemsetAsync((char*)d_ws + WS_CTL, 0, CTL_ZERO_BYTES, stream) != hipSuccess) { fprintf(stderr, "kernel_launch: memset failed\n"); return; }
    Args a{};
    for (int i = 0; i < 25; ++i) a.in[i] = (const float*)d_in[i];
    a.pos = (const int*)d_in[2]; a.out = (float*)d_out; a.ws = (unsigned char*)d_ws;
    hipLaunchKernelGGL(fwd_kernel, dim3(grid), dim3(NWAVES * 64), LDS_BYTES, stream, a);
    const hipError_t le = hipPeekAtLastError();
    if (le != hipSuccess) fprintf(stderr, "kernel_launch: launch failed: %s\n", hipGetErrorName(le));
}
```

```cpp
#include <hip/hip_runtime.h>
#ifndef SLOT_ZS
#define SLOT_ZS 172
#define SLOT_FS 86
#define SLOT_P3S 4
#endif
#include <cstdio>
#include <cstdint>

namespace pg8 {
#define PG8_LAS __attribute__((address_space(3)))
typedef unsigned short bf16_t;
typedef short bf16x8 __attribute__((ext_vector_type(8)));
typedef float f32x4 __attribute__((ext_vector_type(4)));
typedef unsigned u32x4 __attribute__((ext_vector_type(4)));
typedef unsigned u32x2 __attribute__((ext_vector_type(2)));
typedef int i32x4 __attribute__((ext_vector_type(4)));
constexpr int BM = 256, BK = 64, HALF = 128, HTB = HALF * BK * 2  , STAGE_BYTES = 8 * HTB, NXCD = 8, WGM = 8;

__host__ __device__ __forceinline__ int lds_byte(int r, int c) { const int st = (r >> 4) * 2 + (c >> 5), rr = r & 15, cc = c & 31, ob = rr * 64 + cc * 2; return st * 1024 + (ob ^ (((ob >> 9) & 1) << 5)); }
__host__ __device__ __forceinline__ void stage_rc(int b, int& R, int& C) { const int st = b / 1024, sb = b % 1024, swz = sb ^ (((sb >> 9) & 1) << 5); R = (st >> 1) * 16 + swz / 64; C = (st & 1) * 32 + (swz % 64) / 2; }
__host__ __device__ __forceinline__ int perm32(int rho) { const int n = rho >> 4, i = rho & 15; return 8 * (i >> 2) + 4 * n + (i & 3); }

struct Unit { int pm, pn; };
struct Gemm { const bf16_t* A; const bf16_t* Bt; int M, N, K, lda, ldb; };

struct StaticOrder {
    int nM, nN, nwg, G, c, stride, cnt;
    __host__ __device__ void init(int M, int N, int G_, int c_) { nM = M / BM; nN = N / BM; nwg = nM * nN; G = G_; c = c_; stride = G_; cnt = 0x7fffffff; }
    __host__ __device__ bool next(int i, Unit& u) const {
        const long L = (long)i * stride + c; if (i >= cnt || L >= nwg) return false;
        int wgid = (int)L; { const int q = nwg / NXCD, r = nwg % NXCD, xcd = wgid % NXCD, off = wgid / NXCD; wgid = (xcd < r ? xcd * (q + 1) : r * (q + 1) + (xcd - r) * q) + off; }
        const int nig = WGM * nN, gid = wgid / nig, fm = gid * WGM, gsz = (nM - fm) < WGM ? (nM - fm) : WGM;
        u.pm = fm + ((wgid % nig) % gsz); u.pn = (wgid % nig) / gsz; return true;
    }
    __device__ __forceinline__ void a_ready(const Unit&) const {}
    __device__ __forceinline__ void done(const Unit&) const {}
};

typedef __bf16 bf16x2_t __attribute__((ext_vector_type(2)));
typedef float f32x2_t __attribute__((ext_vector_type(2)));
__device__ __forceinline__ unsigned cvt_pk_bf16(float lo, float hi) { const f32x2_t v = {lo, hi}; const bf16x2_t b = __builtin_convertvector(v, bf16x2_t); return __builtin_bit_cast(unsigned, b); }
__device__ __forceinline__ float bf_lo(unsigned w) { return __uint_as_float(w << 16); }
__device__ __forceinline__ float bf_hi(unsigned w) { return __uint_as_float(w & 0xffff0000u); }
__device__ __forceinline__ float sigm(float v) { return __builtin_amdgcn_rcpf(1.0f + __builtin_amdgcn_exp2f(-1.4426950408889634f * v)); }
__device__ __forceinline__ f32x4 sigm4(f32x4 v) { return (f32x4){sigm(v[0]), sigm(v[1]), sigm(v[2]), sigm(v[3])}; }
__device__ __forceinline__ u32x4 pack8(f32x4 v0, f32x4 v1) { u32x4 w; w.x = cvt_pk_bf16(v0[0], v0[1]); w.y = cvt_pk_bf16(v0[2], v0[3]); w.z = cvt_pk_bf16(v1[0], v1[1]); w.w = cvt_pk_bf16(v1[2], v1[3]); return w; }

struct EpiF32 {
    static constexpr bool PERM = false, AFTER_DRAIN = false;
    float* C; int ldc;
    __device__ __forceinline__ void operator()(const f32x4 (&acc)[2][2][4][2], const Unit& u, int wr, int wc, int fr, int fq) const {
        const int row0 = u.pm * BM + wr * 64 + fr, col0 = u.pn * BM + wc * 32 + 4 * fq;
#pragma unroll
        for (int ai = 0; ai < 2; ++ai)
#pragma unroll
            for (int m = 0; m < 4; ++m) { float* rowp = C + (size_t)(row0 + ai * HALF + m * 16) * ldc + col0;
#pragma unroll
                for (int bj = 0; bj < 2; ++bj)
#pragma unroll
                    for (int n = 0; n < 2; ++n) *(f32x4*)(rowp + bj * HALF + n * 16) = acc[ai][bj][m][n]; }
    }
};
struct EpiZG {
    static constexpr bool PERM = true, AFTER_DRAIN = false;
    bf16_t* Z; bf16_t* G;
    __device__ __forceinline__ void operator()(const f32x4 (&acc)[2][2][4][2], const Unit& u, int wr, int wc, int fr, int fq) const {
        const int row0 = u.pm * BM + wr * 64 + fr; const bool isg = u.pn >= 15;
        const int ldc = isg ? 8192 : 3840; bf16_t* base = isg ? G : Z; const int col0 = (isg ? (u.pn - 15) : u.pn) * BM + wc * 32 + 8 * fq;
#pragma unroll
        for (int ai = 0; ai < 2; ++ai)
#pragma unroll
            for (int m = 0; m < 4; ++m) { bf16_t* rowp = base + (size_t)(row0 + ai * HALF + m * 16) * ldc + col0;
#pragma unroll
                for (int bj = 0; bj < 2; ++bj) { f32x4 v0 = acc[ai][bj][m][0], v1 = acc[ai][bj][m][1];
                    if (isg) { v0 = sigm4(v0); v1 = sigm4(v1); }
                    *(u32x4*)(rowp + bj * HALF) = pack8(v0, v1); } }
    }
};
struct EpiBf16Scale {
    static constexpr bool PERM = true, AFTER_DRAIN = false;
    bf16_t* O; int ldc; const float* colscale; const float* rowscale;
    __device__ __forceinline__ void operator()(const f32x4 (&acc)[2][2][4][2], const Unit& u, int wr, int wc, int fr, int fq) const {
        const int row0 = u.pm * BM + wr * 64 + fr, col0 = u.pn * BM + wc * 32 + 8 * fq;
        f32x4 cs[2][2];
#pragma unroll
        for (int bj = 0; bj < 2; ++bj)
#pragma unroll
            for (int n = 0; n < 2; ++n) cs[bj][n] = colscale ? *(const f32x4*)(colscale + col0 + bj * HALF + 4 * n) : (f32x4){1.f, 1.f, 1.f, 1.f};
        float rvs[2][4];
#pragma unroll
        for (int ai = 0; ai < 2; ++ai)
#pragma unroll
            for (int m = 0; m < 4; ++m) rvs[ai][m] = rowscale ? rowscale[row0 + ai * HALF + m * 16] : 1.f;
#pragma unroll
        for (int ai = 0; ai < 2; ++ai)
#pragma unroll
            for (int m = 0; m < 4; ++m) { const int r = row0 + ai * HALF + m * 16; const float rs = rvs[ai][m]; bf16_t* rowp = O + (size_t)r * ldc + col0;
#pragma unroll
                for (int bj = 0; bj < 2; ++bj) { const f32x4 v0 = acc[ai][bj][m][0] * cs[bj][0] * rs, v1 = acc[ai][bj][m][1] * cs[bj][1] * rs;
                    *(u32x4*)(rowp + bj * HALF) = pack8(v0, v1); } }
    }
};
struct EpiQ {
    static constexpr bool PERM = true, AFTER_DRAIN = false;
    bf16_t* O; const float* rstd; const float* cosT; const float* sinT;
    __device__ __forceinline__ void operator()(const f32x4 (&acc)[2][2][4][2], const Unit& u, int wr, int wc, int fr, int fq) const {
        const int row0 = u.pm * BM + wr * 64 + fr, col0 = u.pn * BM + wc * 32 + 8 * fq;
        bool rope[2]; int i0[2];
#pragma unroll
        for (int bj = 0; bj < 2; ++bj) { const int c = col0 + bj * HALF, dd = c % 192; rope[bj] = dd >= 128; i0[bj] = rope[bj] ? (dd - 128) >> 1 : 0; }
        float rvs[2][4];
#pragma unroll
        for (int ai = 0; ai < 2; ++ai)
#pragma unroll
            for (int m = 0; m < 4; ++m) rvs[ai][m] = rstd[row0 + ai * HALF + m * 16];
#pragma unroll
        for (int am = 0; am < 4; ++am) { const int ai = am >> 1;
            f32x4 csv[4][2], snv[4][2];
#pragma unroll
            for (int m = 2 * (am & 1); m < 2 * (am & 1) + 2; ++m)
#pragma unroll
                for (int bj = 0; bj < 2; ++bj) if (rope[bj]) { const int r = row0 + ai * HALF + m * 16; csv[m][bj] = *(const f32x4*)(cosT + (size_t)r * 32 + i0[bj]); snv[m][bj] = *(const f32x4*)(sinT + (size_t)r * 32 + i0[bj]); }
#pragma unroll
            for (int m = 2 * (am & 1); m < 2 * (am & 1) + 2; ++m) { const int r = row0 + ai * HALF + m * 16; const float rs = rvs[ai][m]; bf16_t* rowp = O + (size_t)r * 3072 + col0;
#pragma unroll
                for (int bj = 0; bj < 2; ++bj) { f32x4 v0 = acc[ai][bj][m][0] * rs, v1 = acc[ai][bj][m][1] * rs;
                    if (rope[bj]) { const f32x4 cs = csv[m][bj], sn = snv[m][bj];
                        const f32x4 a = v0, b = v1;
                        v0[0] = a[0] * cs[0] - a[1] * sn[0]; v0[1] = a[0] * sn[0] + a[1] * cs[0]; v0[2] = a[2] * cs[1] - a[3] * sn[1]; v0[3] = a[2] * sn[1] + a[3] * cs[1];
                        v1[0] = b[0] * cs[2] - b[1] * sn[2]; v1[1] = b[0] * sn[2] + b[1] * cs[2]; v1[2] = b[2] * cs[3] - b[3] * sn[3]; v1[3] = b[2] * sn[3] + b[3] * cs[3]; }
                    *(u32x4*)(rowp + bj * HALF) = pack8(v0, v1); } } }
    }
};
struct EpiGateMulBf16 {
    static constexpr bool PERM = true, AFTER_DRAIN = false;
    bf16_t* T; const bf16_t* Gt;
    __device__ __forceinline__ void operator()(const f32x4 (&acc)[2][2][4][2], const Unit& u, int wr, int wc, int fr, int fq) const {
        const int row0 = u.pm * BM + wr * 64 + fr, col0 = u.pn * BM + wc * 32 + 8 * fq;
#pragma unroll
        for (int ai = 0; ai < 2; ++ai) {
            u32x4 gv[4][2];
#pragma unroll
            for (int m = 0; m < 4; ++m)
#pragma unroll
                for (int bj = 0; bj < 2; ++bj) gv[m][bj] = *(const u32x4*)(Gt + (size_t)(row0 + ai * HALF + m * 16) * 8192 + col0 + bj * HALF);
#pragma unroll
            for (int m = 0; m < 4; ++m) { const int r = row0 + ai * HALF + m * 16; bf16_t* rowp = T + (size_t)r * 4096 + col0;
#pragma unroll
                for (int bj = 0; bj < 2; ++bj) { const u32x4 g = gv[m][bj];
                    const f32x4 g0 = {bf_lo(g.x), bf_hi(g.x), bf_lo(g.y), bf_hi(g.y)}, g1 = {bf_lo(g.z), bf_hi(g.z), bf_lo(g.w), bf_hi(g.w)};
                    *(u32x4*)(rowp + bj * HALF) = pack8(acc[ai][bj][m][0] * g0, acc[ai][bj][m][1] * g1); } } }
    }
};
struct EpiGateAddBf16 {
    static constexpr bool PERM = true, AFTER_DRAIN = false;
    bf16_t* O; const bf16_t* T; const bf16_t* Gt;
    __device__ __forceinline__ void operator()(const f32x4 (&acc)[2][2][4][2], const Unit& u, int wr, int wc, int fr, int fq) const {
        const int row0 = u.pm * BM + wr * 64 + fr, col0 = u.pn * BM + wc * 32 + 8 * fq;
#pragma unroll
        for (int ai = 0; ai < 2; ++ai) {
            u32x4 gv[4][2], tv[4][2];
#pragma unroll
            for (int m = 0; m < 4; ++m)
#pragma unroll
                for (int bj = 0; bj < 2; ++bj) { const int r = row0 + ai * HALF + m * 16; gv[m][bj] = *(const u32x4*)(Gt + (size_t)r * 8192 + col0 + bj * HALF); tv[m][bj] = *(const u32x4*)(T + (size_t)r * 4096 + col0 + bj * HALF); }
#pragma unroll
            for (int m = 0; m < 4; ++m) { const int r = row0 + ai * HALF + m * 16; bf16_t* rowp = O + (size_t)r * 4096 + col0;
#pragma unroll
                for (int bj = 0; bj < 2; ++bj) { const u32x4 g = gv[m][bj], t = tv[m][bj];
                    const f32x4 g0 = {bf_lo(g.x), bf_hi(g.x), bf_lo(g.y), bf_hi(g.y)}, g1 = {bf_lo(g.z), bf_hi(g.z), bf_lo(g.w), bf_hi(g.w)};
                    const f32x4 t0 = {bf_lo(t.x), bf_hi(t.x), bf_lo(t.y), bf_hi(t.y)}, t1 = {bf_lo(t.z), bf_hi(t.z), bf_lo(t.w), bf_hi(t.w)};
                    *(u32x4*)(rowp + bj * HALF) = pack8(t0 + acc[ai][bj][m][0] * g0, t1 + acc[ai][bj][m][1] * g1); } } }
    }
};
struct EpiSwiGLU {
    static constexpr bool PERM = true, AFTER_DRAIN = false;
    bf16_t* O;
    __device__ __forceinline__ void operator()(const f32x4 (&acc)[2][2][4][2], const Unit& u, int wr, int wc, int fr, int fq) const {
        const int row0 = u.pm * BM + wr * 64 + fr, col0 = u.pn * 128 + wc * 16 + 4 * fq;
#pragma unroll
        for (int ai = 0; ai < 2; ++ai)
#pragma unroll
            for (int m = 0; m < 4; ++m) { bf16_t* rowp = O + (size_t)(row0 + ai * HALF + m * 16) * 11008 + col0;
#pragma unroll
                for (int bj = 0; bj < 2; ++bj) { const f32x4 gt = acc[ai][bj][m][0], up = acc[ai][bj][m][1]; const f32x4 a = gt * sigm4(gt) * up;
                    u32x2 w; w.x = cvt_pk_bf16(a[0], a[1]); w.y = cvt_pk_bf16(a[2], a[3]); *(u32x2*)(rowp + bj * 64) = w; } }
    }
};
struct EpiPle {
    static constexpr bool PERM = true, AFTER_DRAIN = false;
    bf16_t* T;
    __device__ __forceinline__ void operator()(const f32x4 (&acc)[2][2][4][2], const Unit& u, int wr, int wc, int fr, int fq) const {
        const int row0 = u.pm * BM + wr * 64 + fr, col0 = u.pn * BM + wc * 32 + 8 * fq;
#pragma unroll
        for (int ai = 0; ai < 2; ++ai)
#pragma unroll
            for (int m = 0; m < 4; ++m) { bf16_t* rowp = T + (size_t)(row0 + ai * HALF + m * 16) * 4096 + col0;
#pragma unroll
                for (int bj = 0; bj < 2; ++bj) { const u32x4 t = *(const u32x4*)(rowp + bj * HALF);
                    const f32x4 t0 = {bf_lo(t.x), bf_hi(t.x), bf_lo(t.y), bf_hi(t.y)}, t1 = {bf_lo(t.z), bf_hi(t.z), bf_lo(t.w), bf_hi(t.w)};
                    *(u32x4*)(rowp + bj * HALF) = pack8(t0 * sigm4(acc[ai][bj][m][0]), t1 * sigm4(acc[ai][bj][m][1])); }
                asm volatile("" ::: "memory"); }
    }
};

__device__ __forceinline__ f32x4 i2f4(f32x4 a) { const i32x4 i = __builtin_bit_cast(i32x4, a); return (f32x4){(float)i[0], (float)i[1], (float)i[2], (float)i[3]}; }
struct EpiGate8 {
    static constexpr bool PERM = true, AFTER_DRAIN = false, TWICE = false;
    bf16_t* G; const float* rs; const float* cs;
    __device__ __forceinline__ void operator()(const f32x4 (&acc)[2][2][4][2], const Unit& u, int wr, int wc, int fr, int fq) const {
        const int row0 = u.pm * BM + wr * 64 + fr, col0 = u.pn * BM + wc * 32 + 8 * fq;
        f32x4 cv[2][2];
#pragma unroll
        for (int bj = 0; bj < 2; ++bj)
#pragma unroll
            for (int n = 0; n < 2; ++n) cv[bj][n] = *(const f32x4*)(cs + col0 + bj * HALF + 4 * n);
        float rvs[2][4];
#pragma unroll
        for (int ai = 0; ai < 2; ++ai)
#pragma unroll
            for (int m = 0; m < 4; ++m) rvs[ai][m] = rs[row0 + ai * HALF + m * 16];
#pragma unroll
        for (int ai = 0; ai < 2; ++ai)
#pragma unroll
            for (int m = 0; m < 4; ++m) { const int r = row0 + ai * HALF + m * 16; const float rv = rvs[ai][m]; bf16_t* rowp = G + (size_t)r * 8192 + col0;
#pragma unroll
                for (int bj = 0; bj < 2; ++bj) *(u32x4*)(rowp + bj * HALF) = pack8(sigm4(i2f4(acc[ai][bj][m][0]) * cv[bj][0] * rv), sigm4(i2f4(acc[ai][bj][m][1]) * cv[bj][1] * rv)); }
    }
};
struct EpiPle8 {
    static constexpr bool PERM = true, AFTER_DRAIN = false, TWICE = false;
    bf16_t* T; const float* rs; const float* cs;
    __device__ __forceinline__ void operator()(const f32x4 (&acc)[2][2][4][2], const Unit& u, int wr, int wc, int fr, int fq) const {
        const int row0 = u.pm * BM + wr * 64 + fr, col0 = u.pn * BM + wc * 32 + 8 * fq;
        f32x4 cv[2][2];
#pragma unroll
        for (int bj = 0; bj < 2; ++bj)
#pragma unroll
            for (int n = 0; n < 2; ++n) cv[bj][n] = *(const f32x4*)(cs + col0 + bj * HALF + 4 * n);
        float rvs[2][4];
#pragma unroll
        for (int ai = 0; ai < 2; ++ai)
#pragma unroll
            for (int m = 0; m < 4; ++m) rvs[ai][m] = rs[row0 + ai * HALF + m * 16];
#pragma unroll
        for (int ai = 0; ai < 2; ++ai) {
            u32x4 tv[4][2];
#pragma unroll
            for (int m = 0; m < 4; ++m)
#pragma unroll
                for (int bj = 0; bj < 2; ++bj) tv[m][bj] = *(const u32x4*)(T + (size_t)(row0 + ai * HALF + m * 16) * 4096 + col0 + bj * HALF);
#pragma unroll
            for (int m = 0; m < 4; ++m) { const int r = row0 + ai * HALF + m * 16; const float rv = rvs[ai][m]; bf16_t* rowp = T + (size_t)r * 4096 + col0;
#pragma unroll
                for (int bj = 0; bj < 2; ++bj) { const u32x4 t = tv[m][bj];
                    const f32x4 t0 = {bf_lo(t.x), bf_hi(t.x), bf_lo(t.y), bf_hi(t.y)}, t1 = {bf_lo(t.z), bf_hi(t.z), bf_lo(t.w), bf_hi(t.w)};
                    *(u32x4*)(rowp + bj * HALF) = pack8(t0 * sigm4(i2f4(acc[ai][bj][m][0]) * cv[bj][0] * rv), t1 * sigm4(i2f4(acc[ai][bj][m][1]) * cv[bj][1] * rv)); } }
            asm volatile("" ::: "memory"); }
    }
};

struct EpiSwiGLU8 {
    static constexpr bool PERM = true, AFTER_DRAIN = false, TWICE = false, B32 = true;
    bf16_t* O; const float* rs; const float* cs;
    __device__ __forceinline__ void operator()(const f32x4 (&acc)[2][2][4][2], const Unit& u, int wr, int wc, int fr, int fq) const {
        const int row0 = u.pm * BM + wr * 64 + fr, col0 = u.pn * 128 + wc * 16 + 4 * fq, c0 = u.pn * BM + wc * 32 + 8 * fq;
        f32x4 cv[2][2];
#pragma unroll
        for (int bj = 0; bj < 2; ++bj)
#pragma unroll
            for (int n = 0; n < 2; ++n) cv[bj][n] = *(const f32x4*)(cs + c0 + bj * HALF + 4 * n);
        float rvs[2][4];
#pragma unroll
        for (int ai = 0; ai < 2; ++ai)
#pragma unroll
            for (int m = 0; m < 4; ++m) rvs[ai][m] = rs[row0 + ai * HALF + m * 16];
#pragma unroll
        for (int ai = 0; ai < 2; ++ai)
#pragma unroll
            for (int m = 0; m < 4; ++m) { const int r = row0 + ai * HALF + m * 16; const float rv = rvs[ai][m]; bf16_t* rowp = O + (size_t)r * 11008 + col0;
#pragma unroll
                for (int bj = 0; bj < 2; ++bj) { const f32x4 gt = i2f4(acc[ai][bj][m][0]) * cv[bj][0] * rv, up = i2f4(acc[ai][bj][m][1]) * cv[bj][1] * rv; const f32x4 a = gt * sigm4(gt) * up;
                    u32x2 w; w.x = cvt_pk_bf16(a[0], a[1]); w.y = cvt_pk_bf16(a[2], a[3]); *(u32x2*)(rowp + bj * 64) = w; } }
    }
};

template <class T, class = void> struct b32_of { static constexpr bool v = false; };
template <class T> struct b32_of<T, decltype((void)T::B32)> { static constexpr bool v = T::B32; };
template <class Epi, class Sched, bool ALIGN_EPI = false, bool SP2 = false, int PADW = 0, bool I8 = false>
__device__ __forceinline__ void gemm_phase(PG8_LAS unsigned char* lds, const Gemm g, const Sched& S, const Epi& E) {
    int tz = threadIdx.x; asm volatile("" : "+v"(tz));
    const int tid = tz, wid = __builtin_amdgcn_readfirstlane(tid >> 6), lane = tid & 63, wr = wid >> 2, wc = wid & 3, fr = lane & 15, fq = lane >> 4;
    int Kl = g.K; asm volatile("" : "+s"(Kl));
    const int K = Kl, nt = K / BK;
    unsigned voffA[2], voffB[2];
#pragma unroll
    for (int i = 0; i < 2; ++i) { int R, C; stage_rc(tid * 16 + i * 8192, R, C); int Rb = Epi::PERM ? ((R & ~31) + perm32(R & 31)) : R;
        if constexpr (b32_of<Epi>::v) Rb = (Rb & ~63) | (((Rb >> 2) & 1) << 5) | (((Rb >> 3) & 7) << 2) | (Rb & 3);
        voffA[i] = (unsigned)(R * g.lda + C) * 2u; voffB[i] = (unsigned)(Rb * g.ldb + C) * 2u; }
    const size_t kstep = (size_t)(BK * 2);
    const size_t hstepA = (size_t)HALF * g.lda * 2, hstepB = (size_t)HALF * g.ldb * 2;
    const size_t tstepA = 2 * hstepA, tstepB = 2 * hstepB;
    const unsigned ldsw = (unsigned)wid * 1024u;
    const int aoff = lds_byte(wr * 64 + fr, fq * 8), boff = lds_byte(wc * 32 + fr, fq * 8);
#define PG8_SA(b, h) (((b) * 2 + (h)) * HTB)
#define PG8_SB(b, h) ((4 + (b) * 2 + (h)) * HTB)
#define PG8_STAGE(bufoff, gbase, voff) do { _Pragma("unroll") for (int _i = 0; _i < 2; ++_i) \
        __builtin_amdgcn_global_load_lds((const unsigned*)((const char*)(gbase) + (voff)[_i]), (PG8_LAS unsigned*)(lds + (bufoff) + ldsw + _i * 8192), 16, 0, 0); } while (0)
#define PG8_LDA(dst, b, h) do { _Pragma("unroll") for (int m = 0; m < 4; ++m) _Pragma("unroll") for (int k = 0; k < 2; ++k) dst[m][k] = *(const PG8_LAS bf16x8*)(lds + PG8_SA(b, h) + aoff + m * 2048 + k * 1024); } while (0)
#define PG8_LDB(dst, b, h) do { _Pragma("unroll") for (int n = 0; n < 2; ++n) _Pragma("unroll") for (int k = 0; k < 2; ++k) dst[n][k] = *(const PG8_LAS bf16x8*)(lds + PG8_SB(b, h) + boff + n * 2048 + k * 1024); } while (0)
#define PG8_MMA(ai, bj, At, Bt) do { __builtin_amdgcn_s_setprio(1); _Pragma("unroll") for (int m = 0; m < 4; ++m) _Pragma("unroll") for (int n = 0; n < 2; ++n) _Pragma("unroll") for (int k = 0; k < 2; ++k) \
        { if constexpr (I8) acc[ai][bj][m][n] = __builtin_bit_cast(f32x4, __builtin_amdgcn_mfma_i32_16x16x64_i8(__builtin_bit_cast(i32x4, Bt[n][k]), __builtin_bit_cast(i32x4, At[m][k]), __builtin_bit_cast(i32x4, acc[ai][bj][m][n]), 0, 0, 0)); \
          else acc[ai][bj][m][n] = __builtin_amdgcn_mfma_f32_16x16x32_bf16(Bt[n][k], At[m][k], acc[ai][bj][m][n], 0, 0, 0); } __builtin_amdgcn_s_setprio(0); } while (0)
#define PG8_WAIT_V(n) asm volatile("s_waitcnt vmcnt(" #n ")" ::: "memory")
#define PG8_WAIT_L(n) asm volatile("s_waitcnt lgkmcnt(" #n ")" ::: "memory")
#define PG8_BAR __builtin_amdgcn_s_barrier()
#define PG8_SCHED __builtin_amdgcn_sched_barrier(0)
    Unit cur, nxt; int ui = 0;
    if (!S.next(0, cur)) return;
    f32x4 acc[2][2][4][2];
#pragma unroll
    for (int a = 0; a < 2; ++a)
#pragma unroll
        for (int b = 0; b < 2; ++b)
#pragma unroll
            for (int m = 0; m < 4; ++m)
#pragma unroll
                for (int n = 0; n < 2; ++n) acc[a][b][m][n] = (f32x4){0.f, 0.f, 0.f, 0.f};
    bf16x8 At[4][2], B0[2][2], B1[2][2];
    const char* cA = (const char*)g.A + (size_t)cur.pm * tstepA; const char* cB = (const char*)g.Bt + (size_t)cur.pn * tstepB;
    S.a_ready(cur);
    if constexpr (SP2) {
        PG8_STAGE(PG8_SB(0, 0), cB, voffB); PG8_STAGE(PG8_SB(0, 1), cB + hstepB, voffB); PG8_STAGE(PG8_SA(0, 0), cA, voffA); PG8_STAGE(PG8_SA(0, 1), cA + hstepA, voffA);
        if (wr == 1) PG8_BAR;
        PG8_WAIT_V(2); PG8_BAR;
        PG8_STAGE(PG8_SB(1, 0), cB + kstep, voffB); PG8_STAGE(PG8_SA(1, 0), cA + kstep, voffA); PG8_STAGE(PG8_SB(1, 1), cB + hstepB + kstep, voffB);
        PG8_WAIT_V(6); PG8_BAR;
    } else {
        PG8_STAGE(PG8_SB(0, 0), cB, voffB); PG8_STAGE(PG8_SA(0, 0), cA, voffA); PG8_STAGE(PG8_SB(0, 1), cB + hstepB, voffB); PG8_STAGE(PG8_SA(0, 1), cA + hstepA, voffA);
        if (wr == 1) PG8_BAR;
        PG8_WAIT_V(4); PG8_BAR;
        PG8_STAGE(PG8_SB(1, 0), cB + kstep, voffB); PG8_STAGE(PG8_SA(1, 0), cA + kstep, voffA); PG8_STAGE(PG8_SB(1, 1), cB + hstepB + kstep, voffB);
        PG8_WAIT_V(6); PG8_BAR;
    }
    for (;;) {
        const bool has_next = S.next(ui + 1, nxt);
        const char* nA = has_next ? (const char*)g.A + (size_t)nxt.pm * tstepA : cA; const char* nB = has_next ? (const char*)g.Bt + (size_t)nxt.pn * tstepB : cB;
        asm volatile(".p2align 6\n\t.fill %0, 4, 0xBF800000" :: "i"(PADW));
        for (int t = 0; t < nt; t += 2) {
            const bool last = (t == nt - 2);
            const char* a1 = cA + (size_t)(t + 1) * kstep;
            const char* a2 = last ? nA : cA + (size_t)(t + 2) * kstep; const char* b2 = last ? nB : cB + (size_t)(t + 2) * kstep;
            const char* a3 = a2 + kstep; const char* b3 = b2 + kstep;
            if (last && has_next) S.a_ready(nxt);
            if constexpr (SP2) {
            PG8_LDB(B0, 0, 0); PG8_LDB(B1, 0, 1); PG8_SCHED; PG8_LDA(At, 0, 0); PG8_STAGE(PG8_SA(1, 1), a1 + hstepA, voffA);
            PG8_WAIT_V(8); PG8_WAIT_L(0); PG8_BAR; PG8_MMA(0, 0, At, B0); PG8_MMA(0, 1, At, B1); PG8_BAR; PG8_SCHED;
            PG8_LDA(At, 0, 1); PG8_STAGE(PG8_SB(0, 0), b2, voffB); PG8_STAGE(PG8_SB(0, 1), b2 + hstepB, voffB); PG8_STAGE(PG8_SA(0, 0), a2, voffA);
            PG8_WAIT_V(8); PG8_WAIT_L(0); PG8_BAR; PG8_MMA(1, 0, At, B0); PG8_MMA(1, 1, At, B1); PG8_BAR; PG8_SCHED;
            PG8_LDB(B0, 1, 0); PG8_LDB(B1, 1, 1); PG8_SCHED; PG8_LDA(At, 1, 0); PG8_STAGE(PG8_SA(0, 1), a2 + hstepA, voffA);
            PG8_WAIT_V(8); PG8_WAIT_L(0); PG8_BAR; PG8_MMA(0, 0, At, B0); PG8_MMA(0, 1, At, B1); PG8_BAR; PG8_SCHED;
            PG8_LDA(At, 1, 1); PG8_STAGE(PG8_SB(1, 0), b3, voffB); PG8_STAGE(PG8_SB(1, 1), b3 + hstepB, voffB); PG8_STAGE(PG8_SA(1, 0), a3, voffA);
            PG8_WAIT_V(8); PG8_WAIT_L(0); PG8_BAR; PG8_MMA(1, 0, At, B0); PG8_MMA(1, 1, At, B1); PG8_BAR; PG8_SCHED;
            } else {
            PG8_LDB(B0, 0, 0); PG8_SCHED; PG8_LDA(At, 0, 0); PG8_STAGE(PG8_SA(1, 1), a1 + hstepA, voffA);
            PG8_WAIT_L(8); PG8_BAR; PG8_WAIT_L(0); PG8_MMA(0, 0, At, B0); PG8_BAR; PG8_SCHED;
            PG8_LDB(B1, 0, 1); PG8_STAGE(PG8_SB(0, 0), b2, voffB);
            PG8_BAR; PG8_WAIT_L(0); PG8_MMA(0, 1, At, B1); PG8_BAR;
            PG8_LDA(At, 0, 1); PG8_STAGE(PG8_SA(0, 0), a2, voffA);
            PG8_BAR; PG8_WAIT_L(0); PG8_MMA(1, 0, At, B0); PG8_BAR; PG8_SCHED;
            PG8_STAGE(PG8_SB(0, 1), b2 + hstepB, voffB);
            PG8_WAIT_V(6); PG8_BAR; PG8_MMA(1, 1, At, B1); PG8_BAR;
            PG8_LDB(B0, 1, 0); PG8_SCHED; PG8_LDA(At, 1, 0); PG8_STAGE(PG8_SA(0, 1), a2 + hstepA, voffA);
            PG8_WAIT_L(8); PG8_BAR; PG8_WAIT_L(0); PG8_MMA(0, 0, At, B0); PG8_BAR; PG8_SCHED;
            PG8_LDB(B1, 1, 1); PG8_STAGE(PG8_SB(1, 0), b3, voffB);
            PG8_BAR; PG8_WAIT_L(0); PG8_MMA(0, 1, At, B1); PG8_BAR;
            PG8_LDA(At, 1, 1); PG8_STAGE(PG8_SA(1, 0), a3, voffA);
            PG8_BAR; PG8_WAIT_L(0); PG8_MMA(1, 0, At, B0); PG8_BAR; PG8_SCHED;
            PG8_STAGE(PG8_SB(1, 1), b3 + hstepB, voffB);
            PG8_WAIT_V(6); PG8_BAR; PG8_MMA(1, 1, At, B1); PG8_BAR;
            }
        }
        if constexpr (ALIGN_EPI) { if (wr == 0) PG8_BAR; }
        E(acc, cur, wr, wc, fr, fq); S.done(cur);
        if (!has_next) break;
        { bf16x8 zf = {0, 0, 0, 0, 0, 0, 0, 0}; asm volatile("" : "+v"(zf));
#pragma unroll
        for (int a = 0; a < 2; ++a)
#pragma unroll
            for (int b = 0; b < 2; ++b)
#pragma unroll
                for (int m = 0; m < 4; ++m)
#pragma unroll
                    for (int n = 0; n < 2; ++n) { asm volatile("" : "+v"(zf));
                        if constexpr (I8) acc[a][b][m][n] = __builtin_bit_cast(f32x4, __builtin_amdgcn_mfma_i32_16x16x64_i8(__builtin_bit_cast(i32x4, zf), __builtin_bit_cast(i32x4, zf), (i32x4){0, 0, 0, 0}, 0, 0, 0));
                        else acc[a][b][m][n] = __builtin_amdgcn_mfma_f32_16x16x32_bf16(zf, zf, (f32x4){0.f, 0.f, 0.f, 0.f}, 0, 0, 0); } }
        cur = nxt; cA = nA; cB = nB; ++ui;
        if constexpr (ALIGN_EPI) { if (wr == 1) PG8_BAR; }
    }
    PG8_WAIT_V(0);
    if constexpr (!ALIGN_EPI) { if (wr == 0) PG8_BAR; }
    PG8_BAR;
#undef PG8_SA
#undef PG8_SB
#undef PG8_STAGE
#undef PG8_LDA
#undef PG8_LDB
#undef PG8_MMA
#undef PG8_WAIT_V
#undef PG8_WAIT_L
#undef PG8_BAR
#undef PG8_SCHED
}
}

namespace att {
#define ATT_LAS __attribute__((address_space(3)))
typedef unsigned short bf16;
typedef short bf16x8 __attribute__((ext_vector_type(8)));
typedef short s16x4 __attribute__((ext_vector_type(4)));
typedef float f32x16 __attribute__((ext_vector_type(16)));
typedef float f32x4 __attribute__((ext_vector_type(4)));
typedef unsigned u32x4 __attribute__((ext_vector_type(4)));
constexpr float SCALE = 0.07216878364870322f;
constexpr float THR = 8.f;
constexpr int SHM_V = 16384, SHM_KN = 16384, SHM_KR = 8192, BUF = SHM_V + SHM_KN + SHM_KR, NBUF = 3;
constexpr int OFF_V = 0, OFF_KN = SHM_V, OFF_KR = SHM_V + SHM_KN, OFF_WS = NBUF * BUF, ATT_LDS_BYTES = OFF_WS + 8 * 256;
#define SBAR() __builtin_amdgcn_sched_barrier(0)
__device__ __forceinline__ int v_st(int k, int c) { const int kk = (k & ~0xC) | ((k & 4) << 1) | ((k & 8) >> 1); return ((kk >> 3) * 4 + (c >> 5)) * 512 + ((kk & 7) * 32 + (c & 31)) * 2; }
__device__ __forceinline__ int v_rd_base(int lane) { return ((lane & 3) << 3) | (((lane >> 2) & 3) << 6) | (((lane >> 4) & 1) << 5) | (((lane >> 5) & 1) << 8); }
constexpr int v_rd_off(int d0, int ks, int half) { return d0 * 512 + ks * 4096 + half * 2048; }
__device__ __forceinline__ int crow(int r, int hi) { return (r & 3) + 8 * (r >> 2) + 4 * hi; }
__device__ __forceinline__ unsigned cvtpk(float lo, float hi) { return pg8::cvt_pk_bf16(lo, hi); }

__device__ __forceinline__ void partialSM(f32x16& p0, f32x16& p1, float& m_reg, float& mn, float& alpha) {
    float pmax = p0[0];
#pragma unroll
    for (int r = 1; r < 16; ++r) pmax = fmaxf(pmax, p0[r]);
#pragma unroll
    for (int r = 0; r < 16; ++r) pmax = fmaxf(pmax, p1[r]);
    { auto rr = __builtin_amdgcn_permlane32_swap(__float_as_uint(pmax), __float_as_uint(pmax), false, false);
      pmax = fmaxf(__uint_as_float(rr[0]), __uint_as_float(rr[1])); }
    constexpr float C2 = 1.4426950408889634f * SCALE;
    if (__builtin_expect(__all((pmax - m_reg) * SCALE <= THR), 1)) { mn = m_reg; alpha = 1.f; }
    else { mn = fmaxf(m_reg, pmax); alpha = __builtin_amdgcn_exp2f((m_reg - mn) * C2); m_reg = mn; }
    const float mnL = -mn * C2;
#pragma unroll
    for (int r = 0; r < 16; ++r) p0[r] = fmaf(p0[r], C2, mnL);
#pragma unroll
    for (int r = 0; r < 16; ++r) p1[r] = fmaf(p1[r], C2, mnL);
#pragma unroll
    for (int r = 0; r < 16; ++r) p0[r] = __builtin_amdgcn_exp2f(p0[r]);
}
__device__ __forceinline__ void finishSM(f32x16& p0, f32x16& p1, float alpha, float& l_reg, bf16x8& pa0, bf16x8& pa1, bf16x8& pa2, bf16x8& pa3) {
#pragma unroll
    for (int r = 0; r < 16; ++r) p1[r] = __builtin_amdgcn_exp2f(p1[r]);
    float ps = 0;
#pragma unroll
    for (int r = 0; r < 16; ++r) ps += p0[r];
#pragma unroll
    for (int r = 0; r < 16; ++r) ps += p1[r];
    { auto rr = __builtin_amdgcn_permlane32_swap(__float_as_uint(ps), __float_as_uint(ps), false, false);
      ps = __uint_as_float(rr[0]) + __uint_as_float(rr[1]); }
    l_reg = l_reg * alpha + ps;
#define PK4(P, B_, OUT) do { unsigned a0 = cvtpk(P[B_+0], P[B_+1]), a1 = cvtpk(P[B_+2], P[B_+3]);                          \
        unsigned b0 = cvtpk(P[B_+4], P[B_+5]), b1 = cvtpk(P[B_+6], P[B_+7]);                                             \
        auto r0 = __builtin_amdgcn_permlane32_swap(a0, b0, false, false); auto r1 = __builtin_amdgcn_permlane32_swap(a1, b1, false, false); \
        u32x4 w = {r0[0], r1[0], r0[1], r1[1]}; OUT = *reinterpret_cast<bf16x8*>(&w); } while (0)
    PK4(p0, 0, pa0); PK4(p0, 8, pa1); PK4(p1, 0, pa2); PK4(p1, 8, pa3);
#undef PK4
}
__device__ __forceinline__ void qkt(f32x16& p0, f32x16& p1, ATT_LAS const char* buf, int r32, int hi, const bf16x8* qr) {
    p0 = f32x16{}; p1 = f32x16{};
    ATT_LAS const char* kn = buf + OFF_KN + r32 * 256; const int xn = (r32 & 15) << 4;
    ATT_LAS const char* kr = buf + OFF_KR + r32 * 128; const int xr = ((r32 >> 1) & 7) << 4;
#define QK_ADDR(s) ((s) < 8 ? kn + (((s) * 32 + hi * 16) ^ xn) : kr + ((((s) - 8) * 32 + hi * 16) ^ xr))
#define QK_LD(X, s0) do { _Pragma("unroll") for (int i_ = 0; i_ < 3; ++i_) { ATT_LAS const char* a_ = QK_ADDR((s0) + i_); X##a[i_] = *(ATT_LAS const bf16x8*)a_; \
        X##b[i_] = *(ATT_LAS const bf16x8*)(a_ + ((s0) + i_ < 8 ? 32 * 256 : 32 * 128)); } } while (0)
#define QK_MM(X, s0) do { _Pragma("unroll") for (int i_ = 0; i_ < 3; ++i_) { p0 = __builtin_amdgcn_mfma_f32_32x32x16_bf16(X##a[i_], qr[(s0) + i_], p0, 0, 0, 0); \
        p1 = __builtin_amdgcn_mfma_f32_32x32x16_bf16(X##b[i_], qr[(s0) + i_], p1, 0, 0, 0); } } while (0)
    bf16x8 Xa[3], Xb[3], Ya[3], Yb[3];
    QK_LD(X, 0); QK_LD(Y, 3); SBAR();
    QK_MM(X, 0); SBAR(); QK_LD(X, 6); SBAR();
    QK_MM(Y, 3); SBAR(); QK_LD(Y, 9); SBAR();
    QK_MM(X, 6); SBAR();
    QK_MM(Y, 9);
#undef QK_ADDR
#undef QK_LD
#undef QK_MM
}
__device__ __forceinline__ void pv_tile(f32x16* o, int vb, bf16x8 pa0, bf16x8 pa1, bf16x8 pa2, bf16x8 pa3) {
#define TRRD(dst, off) asm volatile("ds_read_b64_tr_b16 %0, %1 offset:%2" : "=&v"(dst) : "v"(vb), "i"(off) : "memory")
#define PV_LD(S, d0) do { constexpr int b_ = v_rd_off(d0, 0, 0); TRRD(S##l0, b_); TRRD(S##h0, b_ + 2048); TRRD(S##l1, b_ + 4096); TRRD(S##h1, b_ + 6144); \
        TRRD(S##l2, b_ + 8192); TRRD(S##h2, b_ + 10240); TRRD(S##l3, b_ + 12288); TRRD(S##h3, b_ + 14336); } while (0)
#define PV_MM(S, d0) do { \
        o[d0] = __builtin_amdgcn_mfma_f32_32x32x16_bf16(pa0, (bf16x8){S##l0[0], S##l0[1], S##l0[2], S##l0[3], S##h0[0], S##h0[1], S##h0[2], S##h0[3]}, o[d0], 0, 0, 0);   \
        o[d0] = __builtin_amdgcn_mfma_f32_32x32x16_bf16(pa1, (bf16x8){S##l1[0], S##l1[1], S##l1[2], S##l1[3], S##h1[0], S##h1[1], S##h1[2], S##h1[3]}, o[d0], 0, 0, 0);   \
        o[d0] = __builtin_amdgcn_mfma_f32_32x32x16_bf16(pa2, (bf16x8){S##l2[0], S##l2[1], S##l2[2], S##l2[3], S##h2[0], S##h2[1], S##h2[2], S##h2[3]}, o[d0], 0, 0, 0);   \
        o[d0] = __builtin_amdgcn_mfma_f32_32x32x16_bf16(pa3, (bf16x8){S##l3[0], S##l3[1], S##l3[2], S##l3[3], S##h3[0], S##h3[1], S##h3[2], S##h3[3]}, o[d0], 0, 0, 0); } while (0)
#define PV_W(n) do { asm volatile("s_waitcnt lgkmcnt(" #n ")" ::: "memory"); SBAR(); } while (0)
    s16x4 Al0, Al1, Al2, Al3, Ah0, Ah1, Ah2, Ah3, Bl0, Bl1, Bl2, Bl3, Bh0, Bh1, Bh2, Bh3;
    PV_LD(A, 0); PV_LD(B, 1); PV_W(8); PV_MM(A, 0); SBAR();
    PV_LD(A, 2); PV_W(8); PV_MM(B, 1); SBAR();
    PV_LD(B, 3); PV_W(8); PV_MM(A, 2); SBAR();
    PV_W(0); PV_MM(B, 3);
#undef PV_W
#undef PV_MM
#undef PV_LD
#undef TRRD
}
__device__ __forceinline__ void attn_unit(ATT_LAS char* lds, const bf16* Q, const bf16* KV, const bf16* KRP, bf16* O, int h, int qb) {
    int tz = threadIdx.x; asm volatile("" : "+v"(tz));
    const int tid = tz, wid = __builtin_amdgcn_readfirstlane(tid >> 6), lane = tid & 63, r32 = lane & 31, hi = lane >> 5;
    const int ntw = 4 * qb + (wid >> 1) + 1, NT = 4 * qb + 4;
    bf16x8 qr[12];
    { const bf16* qrow = Q + (size_t)(qb * 256 + wid * 32 + r32) * 3072 + h * 192;
#pragma unroll
      for (int d0 = 0; d0 < 8; ++d0) qr[d0] = *(const bf16x8*)(qrow + d0 * 16 + hi * 8);
#pragma unroll
      for (int d0 = 0; d0 < 4; ++d0) qr[8 + d0] = *(const bf16x8*)(qrow + 128 + d0 * 16 + hi * 8); }
    ATT_LAS float* ws = (ATT_LAS float*)(lds + OFF_WS) + wid * 64; ATT_LAS float* li_l = ws; ATT_LAS float* al_l = ws + 32;
    float m_reg = -1e30f, l_reg = 0.f; f32x16 o[4] = {};
    unsigned offKN[2], offV[2], offKR;
#pragma unroll
    for (int i = 0; i < 2; ++i) { const int p = (wid * 2 + i) * 64 + lane; const int row = p >> 4, j = (p & 15) ^ (row & 15); offKN[i] = (unsigned)(row * 4096 + j * 8) * 2u;
        const int sub = p >> 5, q = p & 31, kk = (sub >> 2) * 8 + (q >> 2), col = (sub & 3) * 32 + (q & 3) * 8, key = (kk & ~0xC) | ((kk & 4) << 1) | ((kk & 8) >> 1);
        offV[i] = (unsigned)(key * 4096 + 128 + col) * 2u; }
    { const int p = wid * 64 + lane, row = p >> 3, j = (p & 7) ^ ((row >> 1) & 7); offKR = (unsigned)(row * 64 + j * 8) * 2u; }
    const int vb0 = (int)(uintptr_t)(lds + OFF_V) + v_rd_base(lane);
    const char* kvh = (const char*)(KV + h * 256);
    const bool grpB = wid >= 4;
#define ATT_GLDS(g, l) __builtin_amdgcn_global_load_lds((const unsigned*)(g), (ATT_LAS unsigned*)(l), 16, 0, 0)
#define ATT_DMA(bo, t) do { const char* kb_ = kvh + (size_t)(t) * (64 * 4096 * 2); const char* rb_ = (const char*)KRP + (size_t)(t) * (64 * 64 * 2); ATT_LAS char* l_ = lds + (bo);  \
        ATT_GLDS(kb_ + offKN[0], l_ + OFF_KN + (wid * 2 + 0) * 1024); ATT_GLDS(kb_ + offKN[1], l_ + OFF_KN + (wid * 2 + 1) * 1024); \
        ATT_GLDS(kb_ + offV[0], l_ + OFF_V + (wid * 2 + 0) * 1024); ATT_GLDS(kb_ + offV[1], l_ + OFF_V + (wid * 2 + 1) * 1024);       \
        ATT_GLDS(rb_ + offKR, l_ + OFF_KR + wid * 1024); } while (0)
#define ATT_RESC(a) do { if (__any((a) < 1.f)) { if (hi == 0) al_l[r32] = (a); asm volatile("s_waitcnt lgkmcnt(0)" ::: "memory");              \
        _Pragma("unroll") for (int d_ = 0; d_ < 4; ++d_) _Pragma("unroll") for (int r = 0; r < 16; ++r) o[d_][r] *= al_l[crow(r, hi)]; } } while (0)
#define ATT_BAR() asm volatile("s_barrier" ::: "memory")
#define ATT_WAIT_BAR() asm volatile("s_waitcnt vmcnt(0)\n\ts_barrier" ::: "memory")
    ATT_DMA(0, 0); ATT_DMA(BUF, 1);
    asm volatile("s_waitcnt vmcnt(0)" ::: "memory");
    if (grpB) { __builtin_amdgcn_s_setprio(1); ATT_BAR(); }
    int bo = 0, bo2 = 2 * BUF;
    for (int t = 0; t < NT; ++t) {
        f32x16 p0, p1; float mn, alpha; bf16x8 pa0, pa1, pa2, pa3;
        ATT_BAR();
        if (t < ntw) { qkt(p0, p1, lds + bo, r32, hi, qr); partialSM(p0, p1, m_reg, mn, alpha); }
        ATT_WAIT_BAR();
        if (t + 2 < NT) ATT_DMA(bo2, t + 2);
        if (t < ntw) { ATT_RESC(alpha); finishSM(p0, p1, alpha, l_reg, pa0, pa1, pa2, pa3); SBAR(); pv_tile(o, vb0 + bo, pa0, pa1, pa2, pa3); }
        bo = (bo == 2 * BUF) ? 0 : bo + BUF; bo2 = (bo2 == 2 * BUF) ? 0 : bo2 + BUF;
    }
    if (!grpB) ATT_BAR();
    __builtin_amdgcn_s_setprio(0);
    if (hi == 0) li_l[r32] = l_reg; asm volatile("s_waitcnt lgkmcnt(0)" ::: "memory");
    bf16* Ow = O + (size_t)(qb * 256 + wid * 32) * 2048 + h * 128;
#pragma unroll
    for (int r = 0; r < 16; ++r) { const int orow = crow(r, hi); const float rl = __builtin_amdgcn_rcpf(li_l[orow]);
#pragma unroll
        for (int d0 = 0; d0 < 4; ++d0) { const float v = o[d0][r] * rl; const float vn = __int_as_float(__builtin_amdgcn_mov_dpp(__float_as_int(v), 0xB1, 0xF, 0xF, true));
            if ((r32 & 1) == 0) *(unsigned*)(Ow + (size_t)orow * 2048 + d0 * 32 + r32) = cvtpk(v, vn); } }
    __syncthreads();
#undef ATT_BAR
#undef ATT_WAIT_BAR
#undef ATT_GLDS
#undef ATT_DMA
#undef ATT_RESC
#undef ATT_STEP
}
#undef SBAR
}

constexpr int NWAVES = 8;
constexpr int S_ = 8192, D_ = 4096, NZ = 3840, INW = 3648, NGATE = 8192, N1 = NZ + NGATE, PW = 2048, QLAT = 1024, KVLAT = 512, KROPE = 64;
constexpr int O1 = 2048, O2 = 3072, O3 = 3584;
constexpr int NHEAD = 16, NQ = 3072, NKV = 4096, MLAW = 2048, FF = 11008, NF1 = 2 * FF, PLE = 256;
constexpr float EPS = 1e-6f;
constexpr size_t MiB = 1u << 20;
constexpr size_t WS_CTL = 0, CTL_ZERO_BYTES = 32768;
constexpr size_t WS_W1 = 2 * MiB, WS_WPOOL = 96 * MiB, WS_WQ = 98 * MiB, WS_WKV = 104 * MiB, WS_WUPA = 108 * MiB, WS_WUPB = 124 * MiB, WS_WOUT = 140 * MiB,
                 WS_WF1 = 172 * MiB, WS_WF2 = 344 * MiB, WS_WPG = 430 * MiB, WS_WPP = 462 * MiB;
constexpr size_t WS_RA = 464 * MiB;
constexpr size_t WS_Z = 592 * MiB;
constexpr size_t WS_X1B = 2 * MiB;
constexpr size_t WS_POOLED = 652 * MiB;
constexpr size_t WS_TMP = 592 * MiB;
constexpr size_t WS_RC = 720 * MiB;
constexpr size_t WS_Q = 784 * MiB, WS_KV = 832 * MiB, WS_MIXED = 896 * MiB, WS_MLAO = 928 * MiB;
constexpr size_t WS_ACT = 784 * MiB;
constexpr size_t WS_PBF = 960 * MiB, WS_COS = 964 * MiB, WS_SIN = 965 * MiB, WS_KROPE = 966 * MiB, WS_RSTD = 967 * MiB;
constexpr size_t WS_H8 = 684 * MiB;
constexpr size_t WS_WG8 = 784 * MiB;
constexpr size_t WS_WPG8 = 968 * MiB;
constexpr size_t WS_SC = 984 * MiB;
constexpr size_t SC_CSG = 0, SC_CSP = 32768, SC_RSH = 65536, SC_RS3 = 98304, SC_CSF = 131072  , SC_RS2 = 229376  , WS_END = 985 * MiB;
constexpr size_t WS_WF18 = 172 * MiB;
static_assert(WS_ACT + (size_t)S_ * FF * 2 <= WS_PBF && WS_W1 + (size_t)N1 * D_ * 2 <= WS_WPOOL && WS_WF1 + (size_t)NF1 * D_ * 2 <= WS_WF2 && WS_WF2 + (size_t)D_ * FF * 2 <= WS_WPG, "d_ws map");
constexpr int CW_BAR = 4096;
static_assert((size_t)(CW_BAR + 3392 + 64) * 4 <= CTL_ZERO_BYTES, "the per-call memset must cover every barrier word (XB_TOPGEN is the last)");
constexpr int RING_BYTES = 131072, LDSCTL_OFF = RING_BYTES, MISC_OFF = LDSCTL_OFF + 320, LDS_BYTES = 147456;
static_assert(att::ATT_LDS_BYTES <= RING_BYTES, "attention LDS");

#define GAS __attribute__((address_space(1)))
#define LAS __attribute__((address_space(3)))
typedef unsigned short bf16;
typedef unsigned v4u __attribute__((ext_vector_type(4)));
typedef unsigned v2u __attribute__((ext_vector_type(2)));
typedef float f32x4 __attribute__((ext_vector_type(4)));
typedef GAS unsigned gu32;
#define RLX_AGENT __ATOMIC_RELAXED, __HIP_MEMORY_SCOPE_AGENT
#define LDS_WAIT() asm volatile("s_waitcnt lgkmcnt(0)" ::: "memory")
__device__ __forceinline__ unsigned f2bf(float f) { unsigned u = __builtin_bit_cast(unsigned, f); return (u + 0x7fffu + ((u >> 16) & 1u)) >> 16; }
__device__ __forceinline__ unsigned pk2(float lo, float hi) { return f2bf(lo) | (f2bf(hi) << 16); }
__device__ __forceinline__ float bflo(unsigned w) { return __uint_as_float(w << 16); }
__device__ __forceinline__ float bfhi(unsigned w) { return __uint_as_float(w & 0xffff0000u); }

#define XB_TMO      128
#define XB_XCNT(j)  (256  + 64 * (j))
#define XB_XSUB(j)  (1280 + 64 * (j))
#define XB_XGEN(j)  (2304 + 64 * (j))
#define XB_TOP      3328
#define XB_TOPGEN   3392
#define XCD_BAR_WORDS 3456
#define XB_SPIN_CAP (1u << 18)
__device__ __forceinline__ unsigned xb_ld(unsigned* p)              { return __hip_atomic_load(p, __ATOMIC_RELAXED, __HIP_MEMORY_SCOPE_AGENT); }
__device__ __forceinline__ unsigned xb_add(unsigned* p, unsigned v) { return __hip_atomic_fetch_add(p, v, __ATOMIC_RELAXED, __HIP_MEMORY_SCOPE_AGENT); }
__device__ __forceinline__ unsigned xb_xcc_id() { return (unsigned)__builtin_amdgcn_s_getreg((3 << 11) | 20) & 0xFu; }
#define XB_SPIN(cond, bar) do { unsigned _sp = 0; while (cond) { __builtin_amdgcn_s_sleep(1); \
    if ((++_sp & 255u) == 0u) { if (xb_ld(&(bar)[XB_TMO])) break; if (_sp > XB_SPIN_CAP) { atomicAdd(&(bar)[XB_TMO], 1u); break; } } } } while (0)
struct XcdBarrier { unsigned* bar; unsigned x; volatile LAS unsigned* st; };
__device__ __forceinline__ XcdBarrier xcd_barrier_post(unsigned* bar, volatile LAS unsigned* st) {
    XcdBarrier b; b.bar = bar; b.x = xb_xcc_id(); b.st = st;
    if (threadIdx.x == 0) (void)xb_add(&bar[XB_XCNT(b.x)], 1u);
    return b;
}
__device__ __forceinline__ void xcd_barrier_complete(unsigned* bar, unsigned x, unsigned& nloc, unsigned& nx) {
    const unsigned G = gridDim.x * gridDim.y * gridDim.z;
    unsigned sum, cnt, mine, sp = 0u;
    for (;;) {
        sum = 0u; cnt = 0u; mine = 0u;
#pragma unroll
        for (unsigned j = 0; j < 16; ++j) { const unsigned c = xb_ld(&bar[XB_XCNT(j)]); sum += c; cnt += (c > 0u) ? 1u : 0u; mine = (j == x) ? c : mine; }
        if (sum == G) break;
        __builtin_amdgcn_s_sleep(1);
        if ((++sp & 255u) == 0u) { if (xb_ld(&bar[XB_TMO])) break; if (sp > XB_SPIN_CAP) { atomicAdd(&bar[XB_TMO], 1u); break; } }
    }
    nloc = mine > 0u ? mine : 1u; nx = cnt > 0u ? cnt : 1u;
}
__device__ __forceinline__ void xcd_barrier(const XcdBarrier& b) {
    asm volatile("s_waitcnt vmcnt(0)" ::: "memory");
    __syncthreads();
    if (threadIdx.x == 0) {
        unsigned* bar = b.bar;
        __builtin_amdgcn_s_waitcnt(0);
        unsigned nloc = b.st[0], nx = b.st[1];
        if (nloc == 0u) { xcd_barrier_complete(bar, b.x, nloc, nx); b.st[0] = nloc; b.st[1] = nx; }
        const unsigned old = xb_add(&bar[XB_XSUB(b.x)], 1u);
        const unsigned gen = old / nloc;
        if (old + 1u == (gen + 1u) * nloc) {
            __builtin_amdgcn_fence(__ATOMIC_RELEASE, "agent");
            asm volatile("s_waitcnt vmcnt(0)" ::: "memory");
            const unsigned og = xb_add(&bar[XB_TOP], 1u);
            const unsigned tg = og / nx;
            if (og + 1u == (tg + 1u) * nx) xb_add(&bar[XB_TOPGEN], 1u);
            else XB_SPIN(xb_ld(&bar[XB_TOPGEN]) == tg, bar);
            __builtin_amdgcn_fence(__ATOMIC_ACQUIRE, "agent");
            xb_add(&bar[XB_XGEN(b.x)], 1u);
            asm volatile("s_waitcnt vmcnt(0)" ::: "memory");
        } else {
            XB_SPIN(xb_ld(&bar[XB_XGEN(b.x)]) == gen, bar);
            __builtin_amdgcn_fence(__ATOMIC_ACQUIRE, "agent");
            asm volatile("s_waitcnt vmcnt(0)" ::: "memory");
        }
    }
    __syncthreads();
}

__device__ __forceinline__ float wave_sum(float v) {
#pragma unroll
    for (int o = 1; o < 64; o <<= 1) v += __shfl_xor(v, o);
    return v;
}
struct TDesc { const float* src; const float* kscale; bf16* drow; int ldw, k0, perm, K; };
__device__ __forceinline__ TDesc tp_resolve(const float* W, const float* W2, const float* kscale, bf16* WT, int K, int Nd, int ldw, int kind, int item, int lane) {
    const int nblk = Nd / 64, kb = item / nblk, nb = item - kb * nblk, k0 = 64 * kb, n0 = 64 * nb;
    const int r = lane >> 4, c4 = (lane & 15) * 4;
    TDesc d; const float* src;
    if (kind == 1) { const int n = n0 + c4, q = n >> 3, s = (n >> 2) & 1; src = (s ? W2 : W) + 4 * q; }
    else src = W + n0 + c4;
    d.src = src + (size_t)(k0 + 2 * r) * ldw; d.kscale = kscale; d.drow = WT + (size_t)(n0 + (lane >> 3)) * K + k0; d.K = K; d.ldw = ldw; d.k0 = k0; d.perm = (kind == 2 && (nb % 3) == 2) ? 1 : 0;
    return d;
}
__device__ __forceinline__ void tp_load(const TDesc& d, f32x4 (&v)[16]) {
#pragma unroll
    for (int i = 0; i < 16; ++i) v[i] = *(const GAS f32x4*)(d.src + (size_t)(8 * (i >> 1) + (i & 1)) * d.ldw);
}
__device__ __forceinline__ void tp_load_nt(const TDesc& d, f32x4 (&v)[16]) {
#pragma unroll
    for (int i = 0; i < 16; ++i) v[i] = __builtin_nontemporal_load((const GAS f32x4*)(d.src + (size_t)(8 * (i >> 1) + (i & 1)) * d.ldw));
}
__device__ __forceinline__ void tp_finish(const TDesc& d, f32x4 (&v)[16], LAS unsigned* scr, int lane) {
    const int r = lane >> 4, c4 = (lane & 15) * 4;
    if (d.kscale) {
#pragma unroll
        for (int i = 0; i < 16; ++i) v[i] = v[i] * d.kscale[d.k0 + 8 * (i >> 1) + 2 * r + (i & 1)];
    }
#pragma unroll
    for (int m = 0; m < 8; ++m) { const f32x4 a = v[2 * m], b = v[2 * m + 1]; v4u w; w.x = pg8::cvt_pk_bf16(a.x, b.x); w.y = pg8::cvt_pk_bf16(a.y, b.y); w.z = pg8::cvt_pk_bf16(a.z, b.z); w.w = pg8::cvt_pk_bf16(a.w, b.w);
        *(LAS v4u*)(scr + (4 * m + r) * 68 + c4) = w; }
    LDS_WAIT(); asm volatile("" ::: "memory");
    const int kc = lane & 7, nl = lane >> 3;
#pragma unroll
    for (int j = 0; j < 8; ++j) { const int n = nl + 8 * j, ncol = d.perm ? 32 * (n & 1) + (n >> 1) : n; const LAS unsigned* s = scr + (4 * kc) * 68 + ncol;
        v4u o; o.x = s[0]; o.y = s[68]; o.z = s[136]; o.w = s[204]; __builtin_nontemporal_store(o, (GAS v4u*)(d.drow + (size_t)(8 * j) * d.K + 8 * kc)); }
    LDS_WAIT(); asm volatile("" ::: "memory");
}

struct Args { const float* in[25]; const int* pos; float* out; unsigned char* ws; };
__device__ __forceinline__ unsigned long long karg_u64(int off) { auto kp = (const __attribute__((address_space(4))) unsigned char*)__builtin_amdgcn_kernarg_segment_ptr(); asm volatile("" : "+s"(kp));
    return *(const __attribute__((address_space(4))) unsigned long long*)(kp + off); }

#define ROWF_LD4(base, i, h) (*(const GAS f32x4*)((const GAS char*)(base) + ((i) >> 1) * 4096 + lo32 + ((i) & 1) * 2048 + (h) * 16))
#define ROWF_ST4(base, i, h) (*(GAS f32x4*)((GAS char*)(base) + ((i) >> 1) * 4096 + lo32 + ((i) & 1) * 2048 + (h) * 16))
#define ROWB_LD8(base, i) (*(const GAS v4u*)((const GAS char*)(base) + ((i) >> 2) * 4096 + lo16 + ((i) & 3) * 1024))
#define ROWB_ST8(base, i) (*(GAS v4u*)((GAS char*)(base) + ((i) >> 2) * 4096 + lo16 + ((i) & 3) * 1024))
#define GAIN_LD4(gl, i, h) (*(const LAS f32x4*)((const LAS char*)(gl) + (i) * 2048 + lo32 + (h) * 16))
__device__ __forceinline__ float sq4(f32x4 a) { return (a.x * a.x + a.y * a.y) + (a.z * a.z + a.w * a.w); }
__device__ __forceinline__ float wave_max(float v) {
#pragma unroll
    for (int o = 1; o < 64; o <<= 1) v = fmaxf(v, __shfl_xor(v, o));
    return v;
}
__device__ __forceinline__ float amax4(f32x4 a) { return fmaxf(fmaxf(fabsf(a.x), fabsf(a.y)), fmaxf(fabsf(a.z), fabsf(a.w))); }
__device__ __forceinline__ unsigned q4(f32x4 a) {
    const int q0 = __float2int_rn(a.x), q1 = __float2int_rn(a.y), q2 = __float2int_rn(a.z), q3 = __float2int_rn(a.w);
    return (unsigned)(q0 & 255) | ((unsigned)(q1 & 255) << 8) | ((unsigned)(q2 & 255) << 16) | ((unsigned)q3 << 24);
}
#define ROWQ_ST8(base, i) (*(GAS v2u*)((GAS char*)(base) + (i) * 512 + lo8))
template <int HN, bool XIB = false, bool XOB = false>
__device__ __forceinline__ void norm_row(const bf16* y, const float* xi, float* xo, const LAS float* g1, const LAS float* g2, bf16* hn, signed char* hq, float* rsc_out, int lane) {
    const unsigned lo32 = (unsigned)lane * 32u, lo16 = (unsigned)lane * 16u, lo8 = (unsigned)lane * 8u;
    f32x4 v[16]; float ss = 0.f;
    v4u xb[XIB ? 8 : 1]; f32x4 xf[XIB ? 1 : 16];
    if constexpr (XIB) {
#pragma unroll
        for (int i = 0; i < 8; ++i) xb[i] = ROWB_LD8((const bf16*)xi, i); }
    else {
#pragma unroll
        for (int i = 0; i < 8; ++i) { xf[2 * i] = ROWF_LD4(xi, i, 0); xf[2 * i + 1] = ROWF_LD4(xi, i, 1); } }
#pragma unroll
    for (int i = 0; i < 8; ++i) { const v4u c = ROWB_LD8(y, i); v[2 * i] = (f32x4){bflo(c.x), bfhi(c.x), bflo(c.y), bfhi(c.y)}; v[2 * i + 1] = (f32x4){bflo(c.z), bfhi(c.z), bflo(c.w), bfhi(c.w)};
        ss += sq4(v[2 * i]) + sq4(v[2 * i + 1]); }
    const float rstd = 1.0f / sqrtf(wave_sum(ss) * (1.0f / D_) + EPS);
    float s2 = 0.f;
#pragma unroll
    for (int i = 0; i < 8; ++i) {
        if constexpr (XIB) { const v4u c = xb[i]; const f32x4 x0 = {bflo(c.x), bfhi(c.x), bflo(c.y), bfhi(c.y)}, x1 = {bflo(c.z), bfhi(c.z), bflo(c.w), bfhi(c.w)};
            v[2 * i] = x0 + v[2 * i] * rstd * GAIN_LD4(g1, i, 0); v[2 * i + 1] = x1 + v[2 * i + 1] * rstd * GAIN_LD4(g1, i, 1); s2 += sq4(v[2 * i]) + sq4(v[2 * i + 1]); }
        else {
#pragma unroll
            for (int h = 0; h < 2; ++h) { const f32x4 xv = xf[2 * i + h], gv = GAIN_LD4(g1, i, h); v[2 * i + h] = xv + v[2 * i + h] * rstd * gv; s2 += sq4(v[2 * i + h]); } } }
#pragma unroll
    for (int i = 0; i < 8; ++i) {
        if constexpr (XOB) { const f32x4 a = v[2 * i], b = v[2 * i + 1]; v4u w; w.x = pk2(a.x, a.y); w.y = pk2(a.z, a.w); w.z = pk2(b.x, b.y); w.w = pk2(b.z, b.w); ROWB_ST8((bf16*)xo, i) = w; }
        else {
#pragma unroll
            for (int h = 0; h < 2; ++h) ROWF_ST4(xo, i, h) = v[2 * i + h]; } }
    if constexpr (HN == 1) {
        const float rstd2 = 1.0f / sqrtf(wave_sum(s2) * (1.0f / D_) + EPS);
#pragma unroll
        for (int i = 0; i < 8; ++i) { const f32x4 a = v[2 * i] * rstd2 * GAIN_LD4(g2, i, 0), b = v[2 * i + 1] * rstd2 * GAIN_LD4(g2, i, 1);
            v4u w; w.x = pk2(a.x, a.y); w.y = pk2(a.z, a.w); w.z = pk2(b.x, b.y); w.w = pk2(b.z, b.w); ROWB_ST8(hn, i) = w; }
    }
    if constexpr (HN == 2) {
        const float rstd2 = 1.0f / sqrtf(wave_sum(s2) * (1.0f / D_) + EPS); float mx = 0.f;
#pragma unroll
        for (int i = 0; i < 8; ++i)
#pragma unroll
            for (int h = 0; h < 2; ++h) { v[2 * i + h] = v[2 * i + h] * rstd2 * GAIN_LD4(g2, i, h); mx = fmaxf(mx, amax4(v[2 * i + h])); }
        mx = fmaxf(wave_max(mx), 1e-30f); const float qs = 127.0f / mx;
        if (lane == 0) *rsc_out = mx * (1.0f / 127.0f);
#pragma unroll
        for (int i = 0; i < 8; ++i) { v2u w; w.x = q4(v[2 * i] * qs); w.y = q4(v[2 * i + 1] * qs); ROWQ_ST8(hq, i) = w; }
    }
}
__device__ __forceinline__ void prenorm_row(const float* xrow, const LAS float* g, bf16* hn, signed char* hq, float* rsc_out, int lane) {
    const unsigned lo32 = (unsigned)lane * 32u, lo16 = (unsigned)lane * 16u, lo8 = (unsigned)lane * 8u;
    f32x4 v[16]; float ss = 0.f;
#pragma unroll
    for (int i = 0; i < 8; ++i)
#pragma unroll
        for (int h = 0; h < 2; ++h) { v[2 * i + h] = ROWF_LD4(xrow, i, h); ss += sq4(v[2 * i + h]); }
    const float rstd = 1.0f / sqrtf(wave_sum(ss) * (1.0f / D_) + EPS); float mx = 0.f;
#pragma unroll
    for (int i = 0; i < 8; ++i) { const f32x4 a = v[2 * i] * rstd * GAIN_LD4(g, i, 0), b = v[2 * i + 1] * rstd * GAIN_LD4(g, i, 1); v[2 * i] = a; v[2 * i + 1] = b; mx = fmaxf(mx, fmaxf(amax4(a), amax4(b)));
        v4u w; w.x = pk2(a.x, a.y); w.y = pk2(a.z, a.w); w.z = pk2(b.x, b.y); w.w = pk2(b.z, b.w); ROWB_ST8(hn, i) = w; }
    mx = fmaxf(wave_max(mx), 1e-30f); const float qs = 127.0f / mx;
    if (lane == 0) *rsc_out = mx * (1.0f / 127.0f);
#pragma unroll
    for (int i = 0; i < 8; ++i) { v2u w; w.x = q4(v[2 * i] * qs); w.y = q4(v[2 * i + 1] * qs); ROWQ_ST8(hq, i) = w; }
}
__device__ __forceinline__ void requant_row(const bf16* wrow, signed char* qrow, float* csc_out, int lane) {
    const unsigned lo16 = (unsigned)lane * 16u, lo8 = (unsigned)lane * 8u;
    f32x4 v[16]; float mx = 0.f;
#pragma unroll
    for (int i = 0; i < 8; ++i) { const v4u c = ROWB_LD8(wrow, i); v[2 * i] = (f32x4){bflo(c.x), bfhi(c.x), bflo(c.y), bfhi(c.y)}; v[2 * i + 1] = (f32x4){bflo(c.z), bfhi(c.z), bflo(c.w), bfhi(c.w)};
        mx = fmaxf(mx, fmaxf(amax4(v[2 * i]), amax4(v[2 * i + 1]))); }
    mx = fmaxf(wave_max(mx), 1e-30f); const float qs = 127.0f / mx;
    if (lane == 0) *csc_out = mx * (1.0f / 127.0f);
#pragma unroll
    for (int i = 0; i < 8; ++i) { v2u w; w.x = q4(v[2 * i] * qs); w.y = q4(v[2 * i + 1] * qs); ROWQ_ST8(qrow, i) = w; }
}
__device__ __forceinline__ void strip32(const float* srcu, int ldw, signed char* qdst, float* cslu, int cstride, LAS unsigned char* lds, LAS float* red, int wave, int par) {
    int tz = threadIdx.x; asm volatile("" : "+v"(tz));
    const int lane = tz & 63, cg = lane & 7, kr = lane >> 3;
    float* csl = cslu + cstride * cg;
    const unsigned voff = (unsigned)((512 * wave + 4 * kr) * ldw + 4 * cg) * 4u;
    const GAS char* pu = (const GAS char*)srcu;
    unsigned P[16][4][2]; f32x4 v[16]; f32x4 mx = {0.f, 0.f, 0.f, 0.f};
#pragma unroll
    for (int j = 0; j < 16; ++j) v[j] = __builtin_nontemporal_load((const GAS f32x4*)(pu + (size_t)((32 * (j >> 2) + (j & 3)) * ldw) * 4 + voff));
    asm volatile("" ::: "memory");
#pragma unroll
    for (int g = 0; g < 16; ++g) { const int b = (g & 3) * 4;
        const f32x4 a0 = v[b], a1 = v[b + 1], a2 = v[b + 2], a3 = v[b + 3];
#pragma unroll
        for (int c = 0; c < 4; ++c) { mx[c] = fmaxf(fmaxf(mx[c], fmaxf(fabsf(a0[c]), fabsf(a1[c]))), fmaxf(fabsf(a2[c]), fabsf(a3[c])));
            P[g][c][0] = pg8::cvt_pk_bf16(a0[c], a1[c]); P[g][c][1] = pg8::cvt_pk_bf16(a2[c], a3[c]);
            asm volatile("" : "+v"(P[g][c][0]), "+v"(P[g][c][1]), "+v"(mx[c])); }
        if (g + 4 < 16) {
#pragma unroll
            for (int t = 0; t < 4; ++t) v[b + t] = __builtin_nontemporal_load((const GAS f32x4*)(pu + (size_t)((32 * (g + 4) + t) * ldw) * 4 + voff));
            asm volatile("" ::: "memory"); } }
#pragma unroll
    for (int c = 0; c < 4; ++c) { float m = mx[c]; m = fmaxf(m, __shfl_xor(m, 8)); m = fmaxf(m, __shfl_xor(m, 16)); m = fmaxf(m, __shfl_xor(m, 32)); mx[c] = bflo(pg8::cvt_pk_bf16(m, m)); }
    LAS float* rp = red + par * 256;
    if (kr == 0) *(LAS f32x4*)(rp + wave * 32 + 4 * cg) = mx;
    __syncthreads();
    f32x4 m8 = *(const LAS f32x4*)(rp + 4 * cg);
#pragma unroll
    for (int w = 1; w < 8; ++w) { const f32x4 r = *(const LAS f32x4*)(rp + w * 32 + 4 * cg);
#pragma unroll
        for (int c = 0; c < 4; ++c) m8[c] = fmaxf(m8[c], r[c]); }
    f32x4 qs;
#pragma unroll
    for (int c = 0; c < 4; ++c) { m8[c] = fmaxf(m8[c], 1e-30f); qs[c] = 127.0f / m8[c]; }
    if (wave == 0 && kr == 0) *(GAS f32x4*)csl = m8 * (1.0f / 127.0f);
    LAS unsigned char* img = lds + wave * 16384;
    const unsigned wbase = (unsigned)(4 * cg) * 512u + 4u * (unsigned)kr, cgx = (unsigned)cg * 32u;
#pragma unroll
    for (int g = 0; g < 16; ++g) { const unsigned col = wbase + (((unsigned)g * 32u) ^ cgx);
#pragma unroll
        for (int c = 0; c < 4; ++c) { const unsigned lo = P[g][c][0], hi = P[g][c][1]; const float s = qs[c];
            const unsigned r0 = __float_as_uint(fmaf(bflo(lo), s, 12582912.0f)), r1 = __float_as_uint(fmaf(bfhi(lo), s, 12582912.0f)),
                           r2 = __float_as_uint(fmaf(bflo(hi), s, 12582912.0f)), r3 = __float_as_uint(fmaf(bfhi(hi), s, 12582912.0f));
            const unsigned t01 = __builtin_amdgcn_perm(r1, r0, 0x0c0c0400u), t23 = __builtin_amdgcn_perm(r3, r2, 0x0c0c0400u);
            *(LAS unsigned*)(img + col + c * 512) = __builtin_amdgcn_perm(t23, t01, 0x05040100u); } }
    const unsigned hi1 = (unsigned)lane >> 5, ch = (unsigned)lane & 31u;
    GAS unsigned char* qp = (GAS unsigned char*)qdst + (size_t)hi1 * D_ + 512u * (unsigned)wave + 16u * ch;
#pragma unroll
    for (int it = 0; it < 16; ++it) { const v4u w = *(const LAS v4u*)(img + (2 * it) * 512 + hi1 * 512u + 16u * (ch ^ (unsigned)(it & ~1)));
        __builtin_nontemporal_store(w, (GAS v4u*)(qp + (size_t)it * 2 * D_)); }
}
template <int W>
__device__ __forceinline__ void pool_load(const bf16* zp, int t, v4u (&c)[W]) {
    const int cnt = (t + 1 < W) ? t + 1 : W;
#pragma unroll
    for (int j = 0; j < W; ++j) { const int jj = j < cnt ? j : 0; c[j] = *(const GAS v4u*)(zp - (size_t)jj * NZ); }
}
template <int W>
__device__ __forceinline__ void pool_finish(const v4u (&c)[W], bf16* op, int t) {
    const int cnt = (t + 1 < W) ? t + 1 : W;
    float a[8];
    a[0] = bflo(c[0].x); a[1] = bfhi(c[0].x); a[2] = bflo(c[0].y); a[3] = bfhi(c[0].y); a[4] = bflo(c[0].z); a[5] = bfhi(c[0].z); a[6] = bflo(c[0].w); a[7] = bfhi(c[0].w);
    float u0[8];
#pragma unroll
    for (int e = 0; e < 8; ++e) u0[e] = a[e];
#pragma unroll
    for (int j = 1; j < W; ++j) { const float wj = j < cnt ? 1.0f : 0.0f;
        a[0] = fmaf(wj, bflo(c[j].x), a[0]); a[1] = fmaf(wj, bfhi(c[j].x), a[1]); a[2] = fmaf(wj, bflo(c[j].y), a[2]); a[3] = fmaf(wj, bfhi(c[j].y), a[3]);
        a[4] = fmaf(wj, bflo(c[j].z), a[4]); a[5] = fmaf(wj, bfhi(c[j].z), a[5]); a[6] = fmaf(wj, bflo(c[j].w), a[6]); a[7] = fmaf(wj, bfhi(c[j].w), a[7]); }
    const float ic = 1.0f / (float)cnt;
    v4u o; o.x = pk2(a[0] * ic - u0[0], a[1] * ic - u0[1]); o.y = pk2(a[2] * ic - u0[2], a[3] * ic - u0[3]); o.z = pk2(a[4] * ic - u0[4], a[5] * ic - u0[5]); o.w = pk2(a[6] * ic - u0[6], a[7] * ic - u0[7]);
    *(GAS v4u*)op = o;
}
template <int W>
__device__ __forceinline__ void pool_group(const bf16* Z, bf16* POOLED, int g, int gw, int NGW, int lane) {
    for (int t = gw; t < S_; t += 2 * NGW) { const int t2 = t + NGW; const bool two = t2 < S_;
        const bf16* zp = Z + (size_t)t * NZ + g * 512 + lane * 8; const bf16* zp2 = Z + (size_t)(two ? t2 : t) * NZ + g * 512 + lane * 8;
        v4u c1[W], c2[W];
        pool_load<W>(zp, t, c1); pool_load<W>(zp2, two ? t2 : t, c2);
        pool_finish<W>(c1, POOLED + (size_t)t * PW + g * 512 + lane * 8, t);
        if (two) pool_finish<W>(c2, POOLED + (size_t)t2 * PW + g * 512 + lane * 8, t2); }
}
__device__ __forceinline__ void stage_gain(LAS unsigned char* lds, int off, const float* g, int) {
    int tz = threadIdx.x; asm volatile("" : "+v"(tz));
    for (int i = tz; i < D_ / 4; i += NWAVES * 64) *(LAS f32x4*)(lds + off + i * 16) = *(const GAS f32x4*)(g + i * 4);
}

#ifndef GPAD0
#define GPAD0 8
#endif
#ifndef GPAD1
#define GPAD1 8
#endif
#ifndef GPAD2
#define GPAD2 13
#endif
#ifndef GPAD3
#define GPAD3 13
#endif
#ifndef GPAD4
#define GPAD4 8
#endif
#ifndef GPAD5
#define GPAD5 8
#endif
#ifndef GPAD6
#define GPAD6 8
#endif
#ifndef GPAD7
#define GPAD7 8
#endif
#ifndef GPAD8
#define GPAD8 2
#endif
#ifndef GPAD9
#define GPAD9 8
#endif
#ifndef GPAD10
#define GPAD10 8
#endif
#ifndef GPAD11
#define GPAD11 8
#endif
#ifndef PHASE_MASK
#define PHASE_MASK 0xFFFF
#endif
#define PH(k) constexpr ((PHASE_MASK >> (k)) & 1)
#ifndef REP_PHASE
#define REP_PHASE -1
#endif
#define NREP(k) (((k) == REP_PHASE) ? 2 : 1)
__global__ void __launch_bounds__(NWAVES * 64, 2) fwd_kernel(Args args) {
    extern __shared__ __attribute__((aligned(16))) unsigned char lds_raw[];
    LAS unsigned char* lds = (LAS unsigned char*)lds_raw;
    volatile LAS unsigned* MISC = (volatile LAS unsigned*)(lds + MISC_OFF);
    const int tid = threadIdx.x, lane = tid & 63, wave = __builtin_amdgcn_readfirstlane(tid >> 6);
    const int G = gridDim.x, bx = blockIdx.x;
    const int vcu = (G % 8 == 0) ? (bx % 8) * (G / 8) + bx / 8 : bx;
    const int gw = vcu * NWAVES + wave, NGW = G * NWAVES;
    (void)args;
#define INP(i) ((const float*)(const GAS float*)karg_u64(8 * (i)))
#define WSB ((unsigned char*)(GAS unsigned char*)karg_u64(216))
#define OUTP ((float*)(GAS float*)karg_u64(208))
    for (int u = tid; u < (LDS_BYTES - LDSCTL_OFF) / 4; u += NWAVES * 64) ((LAS unsigned*)(lds + LDSCTL_OFF))[u] = 0u;
    __syncthreads();
    XcdBarrier bar = xcd_barrier_post((unsigned*)(WSB + WS_CTL) + CW_BAR, MISC + 8);
#define GRID_BAR() xcd_barrier(bar)

#define WSP(T, off) ((T*)(WSB + (off)))
    constexpr int ZS = SLOT_ZS, FS = SLOT_FS;
    constexpr int P3ITEMS = 8192, P3STRIPS = SLOT_P3S;
    static_assert(32 * SLOT_ZS + 64 * SLOT_FS == (FF / 64) * (D_ / 64), "the tail slots take exactly the W_ffn_down items; the attention-phase converters the 8192 items after them");
    const int DEFER = (G == 256) ? 32 * ZS + 64 * FS + P3ITEMS : 0;
    const int NS3 = (G == 256) ? 16 * P3STRIPS : 0;
    constexpr int NS_G = NGATE / 32, NS_P = D_ / 32, NS_F = NF1 / 32, NSTRIPS = NS_G + NS_P + NS_F;
#define STRIP_DO(s_, par_) do { const float* src; signed char* Q8; float* csl; int ldw, cst, sl = (s_);                                                                             \
        if (sl < NS_G) { src = INP(14) + 32 * sl; Q8 = WSP(signed char, WS_WG8); csl = WSP(float, WS_SC + SC_CSG) + 32 * sl; ldw = NGATE; cst = 4; }                                 \
        else if ((sl -= NS_G) < NS_P) { src = INP(22) + 32 * sl; Q8 = WSP(signed char, WS_WPG8); csl = WSP(float, WS_SC + SC_CSP) + 32 * sl; ldw = D_; cst = 4; }                    \
        else { sl -= NS_P; src = ((sl & 1) ? INP(19) : INP(18)) + 32 * (sl >> 1); Q8 = WSP(signed char, WS_WF18); csl = WSP(float, WS_SC + SC_CSF) + 64 * (sl >> 1) + 4 * (sl & 1); ldw = FF; cst = 8; } \
        strip32(src, ldw, Q8 + (size_t)sl * 32 * D_, csl, cst, lds, (LAS float*)(lds + MISC_OFF + 4096), wave, (par_)); } while (0)
#define P3_RESOLVE(it_, d_, ln_) do { int r = (it_); if (r < 4096) d_ = tp_resolve(INP(15), nullptr, nullptr, WSP(bf16, WS_WOUT), D_, D_, D_, 0, r, ln_);                           \
        else if (r < 6144) d_ = tp_resolve(INP(12), nullptr, nullptr, WSP(bf16, WS_WUPA), PW, D_, D_, 0, r - 4096, ln_);                                                            \
        else d_ = tp_resolve(INP(13), nullptr, nullptr, WSP(bf16, WS_WUPB), MLAW, D_, D_, 0, r - 6144, ln_); } while (0)
#define P3_CONVERT(lo_, hi_) do { int tz_ = threadIdx.x; asm volatile("" : "+v"(tz_)); const int ln_ = tz_ & 63; LAS unsigned* scr_ = (LAS unsigned*)(lds + wave * 16384);          \
        TDesc d0, d1; f32x4 va[16], vb[16]; int it = (lo_) + wave; const int hi = (hi_);                                                                                            \
        if (it < hi) { P3_RESOLVE(it, d0, ln_); tp_load_nt(d0, va); }                                                                                                               \
        while (it < hi) { const int it1 = it + NWAVES, it2 = it1 + NWAVES; const bool h1 = it1 < hi, h2 = it2 < hi;                                                                  \
            if (h1) { P3_RESOLVE(it1, d1, ln_); tp_load_nt(d1, vb); }                                                                                                               \
            tp_finish(d0, va, scr_, ln_);                                                                                                                                           \
            if (h2) { P3_RESOLVE(it2, d0, ln_); tp_load_nt(d0, va); }                                                                                                               \
            if (h1) tp_finish(d1, vb, scr_, ln_);                                                                                                                                   \
            it = it2; } } while (0)
#define SLOT_CONVERT(lo_, hi_) do { int tz_ = threadIdx.x; asm volatile("" : "+v"(tz_)); const int ln_ = tz_ & 63; LAS unsigned* scr_ = (LAS unsigned*)(lds + wave * 16384);        \
        TDesc d0, d1; f32x4 va[16], vb[16]; int it = (lo_) + wave; const int hi = (hi_);                                                                                            \
        if (it < hi) { d0 = tp_resolve(INP(20), nullptr, nullptr, WSP(bf16, WS_WF2), FF, D_, D_, 0, it, ln_); tp_load_nt(d0, va); }                                                     \
        while (it < hi) { const int it1 = it + NWAVES, it2 = it1 + NWAVES; const bool h1 = it1 < hi, h2 = it2 < hi;                                                                  \
            if (h1) { d1 = tp_resolve(INP(20), nullptr, nullptr, WSP(bf16, WS_WF2), FF, D_, D_, 0, it1, ln_); tp_load_nt(d1, vb); }                                                    \
            tp_finish(d0, va, scr_, ln_);                                                                                                                                           \
            if (h2) { d0 = tp_resolve(INP(20), nullptr, nullptr, WSP(bf16, WS_WF2), FF, D_, D_, 0, it2, ln_); tp_load_nt(d0, va); }                                                    \
            if (h1) tp_finish(d1, vb, scr_, ln_);                                                                                                                                   \
            it = it2; } } while (0)
#pragma unroll 1
    for (int rep_ = 0; rep_ < NREP(0); ++rep_) {
    if PH(0) {
        { bf16* W1 = WSP(bf16, WS_W1); const int nchunk = (NZ - INW) * D_ / 8; for (int i = gw * 64 + lane; i < nchunk; i += NGW * 64) *(GAS v4u*)(W1 + (size_t)INW * D_ + (size_t)i * 8) = (v4u){0u, 0u, 0u, 0u}; }
        { stage_gain(lds, 0, INP(3), tid); __syncthreads();
          const float* x = INP(0); bf16* RC = WSP(bf16, WS_RC); signed char* H8 = WSP(signed char, WS_H8); float* RSH = WSP(float, WS_SC + SC_RSH);
          for (int m = gw; m < S_; m += NGW) { asm volatile("" ::: "memory"); prenorm_row(x + (size_t)m * D_, (const LAS float*)lds, RC + (size_t)m * D_, H8 + (size_t)m * D_, RSH + m, lane); } }
        { const float* p = INP(1); bf16* PBF = WSP(bf16, WS_PBF); const int nchunk = S_ * PLE / 8; for (int i = gw * 64 + lane; i < nchunk; i += NGW * 64) { const f32x4 a = *(const GAS f32x4*)(p + (size_t)i * 8), b = *(const GAS f32x4*)(p + (size_t)i * 8 + 4);
            v4u o; o.x = pk2(a.x, a.y); o.y = pk2(a.z, a.w); o.z = pk2(b.x, b.y); o.w = pk2(b.z, b.w); *(GAS v4u*)(PBF + (size_t)i * 8) = o; } }
        { const int* positions = (const int*)(const GAS int*)karg_u64(200); float* COST = WSP(float, WS_COS); float* SINT = WSP(float, WS_SIN);
        for (int i = gw * 64 + lane; i < S_ * 32; i += NGW * 64) { const int s = i >> 5, k = i & 31; const float inv = powf(10000.0f, -(float)(2 * k) / 64.0f); const float ang = (float)positions[s] * inv;
            COST[i] = cosf(ang); SINT[i] = sinf(ang); } }
        __syncthreads();
        LAS unsigned* scr = (LAS unsigned*)(lds + wave * 16384);
        constexpr int I_IN = (D_ / 64) * (INW / 64), I_POOL1 = (512 / 64) * (512 / 64), I_Q = (QLAT / 64) * (NQ / 64), I_KV = (KVLAT / 64) * (NKV / 64),
                      I_UP = (PW / 64) * (D_ / 64), I_OUT = (D_ / 64) * (D_ / 64), I_F2 = (FF / 64) * (D_ / 64), I_PP = (PLE / 64) * (D_ / 64);
        constexpr int NREG_ALL = I_IN + 4 * I_POOL1 + I_Q + I_KV + 2 * I_UP + I_OUT + I_F2 + I_PP;
        { int par = 0; const int NSTR0 = NSTRIPS - NS3;
#pragma unroll 1
          for (int s = bx; s < NSTR0; s += G, par ^= 1) STRIP_DO(s, par); }
#define TP_RESOLVE(it_, d_) do { int r = (it_); const float* W; const float* W2 = nullptr; const float* ks = nullptr; bf16* WT; int K, Nd, ldw, kind = 0;                    \
            if (r < I_F2) { W = INP(20); WT = WSP(bf16, WS_WF2); K = FF; Nd = D_; ldw = D_; }                                                                            \
            else if ((r -= I_F2) < I_OUT) { W = INP(15); WT = WSP(bf16, WS_WOUT); K = D_; Nd = D_; ldw = D_; }                                                           \
            else if ((r -= I_OUT) < I_UP) { W = INP(12); WT = WSP(bf16, WS_WUPA); K = PW; Nd = D_; ldw = D_; }                                                           \
            else if ((r -= I_UP) < I_UP) { W = INP(13); WT = WSP(bf16, WS_WUPB); K = MLAW; Nd = D_; ldw = D_; }                                                          \
            else if ((r -= I_UP) < I_Q) { W = INP(8); ks = INP(6); WT = WSP(bf16, WS_WQ); K = QLAT; Nd = NQ; ldw = NQ; kind = 2; }                                       \
            else if ((r -= I_Q) < I_KV) { W = INP(9); ks = INP(7); WT = WSP(bf16, WS_WKV); K = KVLAT; Nd = NKV; ldw = NKV; }                                             \
            else if ((r -= I_KV) < I_PP) { W = INP(23); WT = WSP(bf16, WS_WPP); K = PLE; Nd = D_; ldw = D_; }                                                            \
            else if ((r -= I_PP) < 4 * I_POOL1) { const int g = r / I_POOL1; r -= g * I_POOL1; W = INP(10) + (size_t)g * 512 * 512; WT = WSP(bf16, WS_WPOOL) + (size_t)g * 512 * 512; K = 512; Nd = 512; ldw = 512; } \
            else { r -= 4 * I_POOL1; W = INP(5); WT = WSP(bf16, WS_W1); K = D_; Nd = INW; ldw = INW; }                                                                   \
            d_ = tp_resolve(W, W2, ks, WT, K, Nd, ldw, kind, r, lane); } while (0)
        { constexpr int CSTRIP = 32;
          const int NREG = NREG_ALL - DEFER;
          const int NSTR0 = NSTRIPS - NS3; const int s_lo = NSTR0 / G, n_hi = NSTR0 % G;
          const int tavg = (NSTR0 * CSTRIP + NREG + G - 1) / G;
          int r_hi = tavg - CSTRIP * (s_lo + 1); r_hi = r_hi < 0 ? 0 : r_hi;
          const int r_lo = (G > n_hi) ? (NREG - n_hi * r_hi + (G - n_hi) - 1) / (G - n_hi) : 0;
          int lo = bx < n_hi ? bx * r_hi : n_hi * r_hi + (bx - n_hi) * r_lo, hi = lo + (bx < n_hi ? r_hi : r_lo);
          lo = lo > NREG ? NREG : lo; hi = hi > NREG ? NREG : hi;
          TDesc d0, d1; f32x4 va[16], vb[16]; int it = lo + wave;
          if (it < hi) { TP_RESOLVE(it + DEFER, d0); tp_load_nt(d0, va); }
          while (it < hi) {
              const int it1 = it + NWAVES, it2 = it1 + NWAVES; const bool h1 = it1 < hi, h2 = it2 < hi;
              if (h1) { TP_RESOLVE(it1 + DEFER, d1); tp_load_nt(d1, vb); }
              tp_finish(d0, va, scr, lane);
              if (h2) { TP_RESOLVE(it2 + DEFER, d0); tp_load_nt(d0, va); }
              if (h1) tp_finish(d1, vb, scr, lane);
              it = it2; } }
#undef TP_RESOLVE
    }
    GRID_BAR();
    }

#pragma unroll 1
    for (int rep_ = 0; rep_ < NREP(1); ++rep_) {
    if PH(1) {
        { pg8::Gemm g{WSP(bf16, WS_RC), WSP(bf16, WS_W1), S_, NZ, D_, D_, D_}; pg8::StaticOrder so; so.init(S_, NZ, G, bx); pg8::EpiBf16Scale E{WSP(bf16, WS_Z), NZ, nullptr, nullptr};
          pg8::gemm_phase<pg8::EpiBf16Scale, pg8::StaticOrder, true, true, GPAD0>(lds, g, so, E); }
        if (DEFER && bx >= 224) SLOT_CONVERT((bx - 224) * ZS, (bx - 223) * ZS); }
    GRID_BAR();
    }

#pragma unroll 1
    for (int rep_ = 0; rep_ < NREP(13); ++rep_) {
    if PH(1) {
      pg8::Gemm g{WSP(bf16, WS_H8), WSP(bf16, WS_WG8), S_, NGATE, D_ / 2, D_ / 2, D_ / 2}; pg8::StaticOrder so; so.init(S_, NGATE, G, bx);
      pg8::EpiGate8 E{WSP(bf16, WS_RA), WSP(float, WS_SC + SC_RSH), WSP(float, WS_SC + SC_CSG)};
      pg8::gemm_phase<pg8::EpiGate8, pg8::StaticOrder, true, true, GPAD11, true>(lds, g, so, E); }
    }

#pragma unroll 1
    for (int rep_ = 0; rep_ < NREP(2); ++rep_) {
    if PH(2) { int lz_ = threadIdx.x; asm volatile("" : "+v"(lz_)); const int lane = lz_ & 63; (void)lane;
        const bf16* Z = WSP(bf16, WS_Z); bf16* POOLED = WSP(bf16, WS_POOLED);
        pool_group<2>(Z, POOLED, 0, gw, NGW, lane); pool_group<4>(Z, POOLED, 1, gw, NGW, lane); pool_group<8>(Z, POOLED, 2, gw, NGW, lane); pool_group<16>(Z, POOLED, 3, gw, NGW, lane);
        float* RSTDQ = WSP(float, WS_RSTD); float* RSTDKV = RSTDQ + S_; const float* COST = WSP(float, WS_COS); const float* SINT = WSP(float, WS_SIN); bf16* KRP = WSP(bf16, WS_KROPE);
#define SQ8(c, acc_) do { float t_; t_ = bflo(c.x); acc_ += t_ * t_; t_ = bfhi(c.x); acc_ += t_ * t_; t_ = bflo(c.y); acc_ += t_ * t_; t_ = bfhi(c.y); acc_ += t_ * t_; \
                           t_ = bflo(c.z); acc_ += t_ * t_; t_ = bfhi(c.z); acc_ += t_ * t_; t_ = bflo(c.w); acc_ += t_ * t_; t_ = bfhi(c.w); acc_ += t_ * t_; } while (0)
        for (int m0 = gw; m0 < S_; m0 += 4 * NGW) {
            v4u q0[4], q1[4], k0[4]; float x1[4], x2[4], cs[4], sn[4];
#pragma unroll
            for (int j = 0; j < 4; ++j) { int m = m0 + j * NGW; m = m < S_ ? m : m0; const bf16* zr = Z + (size_t)m * NZ;
                q0[j] = *(const GAS v4u*)(zr + O1 + lane * 8); q1[j] = *(const GAS v4u*)(zr + O1 + 512 + lane * 8); k0[j] = *(const GAS v4u*)(zr + O2 + lane * 8);
                const int l32 = lane & 31;
                x1[j] = __uint_as_float((unsigned)zr[O3 + l32] << 16); x2[j] = __uint_as_float((unsigned)zr[O3 + 32 + l32] << 16); cs[j] = COST[m * 32 + l32]; sn[j] = SINT[m * 32 + l32]; }
#pragma unroll
            for (int j = 0; j < 4; ++j) { const int m = m0 + j * NGW; if (m < S_) {
                float sq = 0.f, sk = 0.f;
                SQ8(q0[j], sq); SQ8(q1[j], sq); SQ8(k0[j], sk);
                sq = wave_sum(sq); sk = wave_sum(sk);
                if (lane == 0) { RSTDQ[m] = 1.0f / sqrtf(sq * (1.0f / QLAT) + EPS); RSTDKV[m] = 1.0f / sqrtf(sk * (1.0f / KVLAT) + EPS); }
                if (lane < 32) *(GAS unsigned*)(KRP + (size_t)m * 64 + 2 * lane) = pk2(x1[j] * cs[j] - x2[j] * sn[j], x1[j] * sn[j] + x2[j] * cs[j]); } } }
#undef SQ8
    }
    GRID_BAR();
    }

#pragma unroll 1
    for (int rep_ = 0; rep_ < NREP(3); ++rep_) {
    if PH(3) {
#pragma unroll 1
        for (int g = 0; g < 4; ++g) { pg8::Gemm gm{WSP(bf16, WS_POOLED) + g * 512, WSP(bf16, WS_WPOOL) + (size_t)g * 512 * 512, S_, 512, 512, PW, 512}; pg8::StaticOrder so; so.init(S_, 512, G, (bx + 64 * g) % G);
            pg8::EpiBf16Scale E{WSP(bf16, WS_MIXED) + g * 512, PW, INP(11) + g * 512, nullptr};
            pg8::gemm_phase<pg8::EpiBf16Scale, pg8::StaticOrder, true, true, GPAD1>(lds, gm, so, E); }
        { pg8::Gemm gm{WSP(bf16, WS_Z) + O1, WSP(bf16, WS_WQ), S_, NQ, QLAT, NZ, QLAT}; pg8::StaticOrder so; so.init(S_, NQ, G, bx); pg8::EpiQ E{WSP(bf16, WS_Q), WSP(float, WS_RSTD), WSP(float, WS_COS), WSP(float, WS_SIN)};
          pg8::gemm_phase<pg8::EpiQ, pg8::StaticOrder, true, true, GPAD2>(lds, gm, so, E); }
        { pg8::Gemm gm{WSP(bf16, WS_Z) + O2, WSP(bf16, WS_WKV), S_, NKV, KVLAT, NZ, KVLAT}; pg8::StaticOrder so; so.init(S_, NKV, G, bx);
          if (G == 256) { so.stride = 128; so.cnt = bx < 128 ? 1 : 3; }
          pg8::EpiBf16Scale E{WSP(bf16, WS_KV), NKV, nullptr, WSP(float, WS_RSTD) + S_};
          pg8::gemm_phase<pg8::EpiBf16Scale, pg8::StaticOrder, true, true, GPAD3>(lds, gm, so, E); }
    }
    GRID_BAR();
    }

#pragma unroll 1
    for (int rep_ = 0; rep_ < NREP(4); ++rep_) {
    if PH(4) { const bf16* QB = WSP(bf16, WS_Q); const bf16* KVB = WSP(bf16, WS_KV); const bf16* KRP = WSP(bf16, WS_KROPE); bf16* MLAO = WSP(bf16, WS_MLAO);
      if (G == 256) { const int x = bx & 7, j = bx >> 3;
        if (j < 30) { const int h = x + 8 * (j / 15), a = 3 + j % 15;
#pragma unroll 1
          for (int half = 0; half < 2; ++half) att::attn_unit((ATT_LAS char*)lds, QB, KVB, KRP, MLAO, h, half == 0 ? 34 - a : a - 1); }
        else { const int h = x + 8 * (j - 30), ci = 2 * x + (j - 30);
#pragma unroll 1
          for (int half = 0; half < 2; ++half) att::attn_unit((ATT_LAS char*)lds, QB, KVB, KRP, MLAO, h, 1 - half);
          P3_CONVERT(ci * (P3ITEMS / 16), (ci + 1) * (P3ITEMS / 16));
          { const int tI = (FF / 64) * (D_ / 64); (void)tI; }
#pragma unroll 1
          for (int k = 0; k < P3STRIPS; ++k) STRIP_DO(NSTRIPS - NS3 + ci * P3STRIPS + k, k & 1); } }
      else
      for (int pr = bx; pr < 256; pr += G) { const int j = pr >> 3, h = (pr & 7) + 8 * (j >> 4), ql = j & 15;
#pragma unroll 1
        for (int half = 0; half < 2; ++half) att::attn_unit((ATT_LAS char*)lds, QB, KVB, KRP, MLAO, h, half == 0 ? 31 - ql : ql); } }
    GRID_BAR();
    }

#pragma unroll 1
    for (int rep_ = 0; rep_ < NREP(5); ++rep_) {
    if PH(5) { pg8::Gemm gm{WSP(bf16, WS_MIXED), WSP(bf16, WS_WUPA), S_, D_, PW, PW, PW}; pg8::StaticOrder so; so.init(S_, D_, G, bx); pg8::EpiGateMulBf16 E{WSP(bf16, WS_TMP), WSP(bf16, WS_RA)};
      pg8::gemm_phase<pg8::EpiGateMulBf16, pg8::StaticOrder, true, true, GPAD4>(lds, gm, so, E); }
    if PH(5) { pg8::Gemm gm{WSP(bf16, WS_MLAO), WSP(bf16, WS_WUPB), S_, D_, MLAW, MLAW, MLAW}; pg8::StaticOrder so; so.init(S_, D_, G, bx); pg8::EpiGateAddBf16 E{WSP(bf16, WS_RC), WSP(bf16, WS_TMP), WSP(bf16, WS_RA) + D_};
      pg8::gemm_phase<pg8::EpiGateAddBf16, pg8::StaticOrder, true, true, GPAD5>(lds, gm, so, E); }
    GRID_BAR();
    }

#pragma unroll 1
    for (int rep_ = 0; rep_ < NREP(6); ++rep_) {
    if PH(6) { pg8::Gemm gm{WSP(bf16, WS_RC), WSP(bf16, WS_WOUT), S_, D_, D_, D_, D_}; pg8::StaticOrder so; so.init(S_, D_, G, bx); pg8::EpiBf16Scale E{WSP(bf16, WS_RA), D_, nullptr, nullptr};
      pg8::gemm_phase<pg8::EpiBf16Scale, pg8::StaticOrder, true, true, GPAD6>(lds, gm, so, E); }
    GRID_BAR();
    }

#pragma unroll 1
    for (int rep_ = 0; rep_ < NREP(7); ++rep_) {
    if PH(7) { int lz_ = threadIdx.x; asm volatile("" : "+v"(lz_)); const int lane = lz_ & 63; (void)lane;     stage_gain(lds, 0, INP(4), tid); stage_gain(lds, 16384, INP(16), tid); __syncthreads();
      const bf16* RAF = WSP(bf16, WS_RA); const float* x = INP(0); float* out = OUTP; bf16* RC = WSP(bf16, WS_RC); float* RS2 = WSP(float, WS_SC + SC_RS2);
      bf16* X1B = WSP(bf16, WS_X1B); for (int m = gw; m < S_; m += NGW) { asm volatile("" ::: "memory");   norm_row<2, false, true>(RAF + (size_t)m * D_, x + (size_t)m * D_, (float*)(X1B + (size_t)m * D_), (const LAS float*)lds, (const LAS float*)(lds + 16384), nullptr, (signed char*)RC + (size_t)m * D_, RS2 + m, lane); } }
    GRID_BAR();
    }

#pragma unroll 1
    for (int rep_ = 0; rep_ < NREP(8); ++rep_) {
    if PH(8) { pg8::Gemm gm{WSP(bf16, WS_RC), WSP(bf16, WS_WF18), S_, NF1, D_ / 2, D_ / 2, D_ / 2}; pg8::StaticOrder so; so.init(S_, NF1, G, bx);
      pg8::EpiSwiGLU8 E{WSP(bf16, WS_ACT), WSP(float, WS_SC + SC_RS2), WSP(float, WS_SC + SC_CSF)};
      pg8::gemm_phase<pg8::EpiSwiGLU8, pg8::StaticOrder, true, true, GPAD7, true>(lds, gm, so, E);
      if (DEFER && bx >= 192) SLOT_CONVERT(32 * ZS + (bx - 192) * FS, 32 * ZS + (bx - 191) * FS); }
    GRID_BAR();
    }

#pragma unroll 1
    for (int rep_ = 0; rep_ < NREP(9); ++rep_) {
    if PH(9) { pg8::Gemm gm{WSP(bf16, WS_ACT), WSP(bf16, WS_WF2), S_, D_, FF, FF, FF}; pg8::StaticOrder so; so.init(S_, D_, G, bx); pg8::EpiBf16Scale E{WSP(bf16, WS_RA), D_, nullptr, nullptr};
      pg8::gemm_phase<pg8::EpiBf16Scale, pg8::StaticOrder, true, true, GPAD8>(lds, gm, so, E); }
    GRID_BAR();
    }

#pragma unroll 1
    for (int rep_ = 0; rep_ < NREP(10); ++rep_) {
    if PH(10) { int lz_ = threadIdx.x; asm volatile("" : "+v"(lz_)); const int lane = lz_ & 63; (void)lane;     stage_gain(lds, 0, INP(17), tid); stage_gain(lds, 16384, INP(21), tid); __syncthreads();
      const bf16* RAF = WSP(bf16, WS_RA); float* out = OUTP; signed char* H3Q = WSP(signed char, WS_RC); float* RS3 = WSP(float, WS_SC + SC_RS3);
      bf16* X1B = WSP(bf16, WS_X1B); for (int m = gw; m < S_; m += NGW) { asm volatile("" ::: "memory");   norm_row<2, true, true>(RAF + (size_t)m * D_, (const float*)(X1B + (size_t)m * D_), (float*)(X1B + (size_t)m * D_), (const LAS float*)lds, (const LAS float*)(lds + 16384), nullptr, H3Q + (size_t)m * D_, RS3 + m, lane); } }
    GRID_BAR();
    }

#pragma unroll 1
    for (int rep_ = 0; rep_ < NREP(11); ++rep_) {
    if PH(11) { pg8::Gemm gm{WSP(bf16, WS_PBF), WSP(bf16, WS_WPP), S_, D_, PLE, PLE, PLE}; pg8::StaticOrder so; so.init(S_, D_, G, bx); pg8::EpiBf16Scale E{WSP(bf16, WS_TMP), D_, nullptr, nullptr};
      pg8::gemm_phase<pg8::EpiBf16Scale, pg8::StaticOrder, true, true, GPAD9>(lds, gm, so, E); }
    if PH(11) { pg8::Gemm gm{WSP(bf16, WS_RC), WSP(bf16, WS_WPG8), S_, D_, D_ / 2, D_ / 2, D_ / 2}; pg8::StaticOrder so; so.init(S_, D_, G, bx);
      pg8::EpiPle8 E{WSP(bf16, WS_TMP), WSP(float, WS_SC + SC_RS3), WSP(float, WS_SC + SC_CSP)};
      pg8::gemm_phase<pg8::EpiPle8, pg8::StaticOrder, true, true, GPAD10, true>(lds, gm, so, E); }
    GRID_BAR();
    }

    if PH(12) { int lz_ = threadIdx.x; asm volatile("" : "+v"(lz_)); const int lane = lz_ & 63; (void)lane;     stage_gain(lds, 0, INP(24), tid); __syncthreads();
      const bf16* TMP = WSP(bf16, WS_TMP); float* out = OUTP;
      bf16* X1B = WSP(bf16, WS_X1B); for (int m = gw; m < S_; m += NGW) { asm volatile("" ::: "memory");   norm_row<0, true, false>(TMP + (size_t)m * D_, (const float*)(X1B + (size_t)m * D_), out + (size_t)m * D_, (const LAS float*)lds, nullptr, nullptr, nullptr, nullptr, lane); } }
#undef GRID_BAR
}

extern "C" void kernel_launch(void* const* d_in, const int* in_sizes, int n_in, void* d_out, int out_size, void* d_ws, size_t ws_size, hipStream_t stream) {
    static int grid = 0;
    if (grid == 0) {
        if (n_in != 25 || in_sizes[0] != S_ * D_ || out_size != S_ * D_ || ws_size < WS_END) { fprintf(stderr, "kernel_launch: shape/workspace mismatch (n_in %d, in0 %d, out %d, ws %zu, need %zu); nothing launched\n", n_in, n_in > 0 ? in_sizes[0] : -1, out_size, ws_size, (size_t)WS_END); grid = -1; return; }
        int dev = 0, cus = 0, per_cu = 0;
        if (hipGetDevice(&dev) != hipSuccess || hipDeviceGetAttribute(&cus, hipDeviceAttributeMultiprocessorCount, dev) != hipSuccess) { fprintf(stderr, "kernel_launch: device query failed\n"); grid = -1; return; }
        if (hipFuncSetAttribute((const void*)fwd_kernel, hipFuncAttributeMaxDynamicSharedMemorySize, LDS_BYTES) != hipSuccess) { fprintf(stderr, "kernel_launch: hipFuncSetAttribute failed\n"); grid = -1; return; }
        if (hipOccupancyMaxActiveBlocksPerMultiprocessor(&per_cu, (const void*)fwd_kernel, NWAVES * 64, LDS_BYTES) != hipSuccess || per_cu < 1) fprintf(stderr, "kernel_launch: note: occupancy query reports %d blocks per CU\n", per_cu);
        (void)hipGetLastError();
        grid = cus;
    }
    if (grid < 0) return;
    if (hipMemsetAsync((char*)d_ws + WS_CTL, 0, CTL_ZERO_BYTES, stream) != hipSuccess) { fprintf(stderr, "kernel_launch: memset failed\n"); return; }
    Args a{};
    for (int i = 0; i < 25; ++i) a.in[i] = (const float*)d_in[i];
    a.pos = (const int*)d_in[2]; a.out = (float*)d_out; a.ws = (unsigned char*)d_ws;
    hipLaunchKernelGGL(fwd_kernel, dim3(grid), dim3(NWAVES * 64), LDS_BYTES, stream, a);
    const hipError_t le = hipPeekAtLastError();
    if (le != hipSuccess) fprintf(stderr, "kernel_launch: launch failed: %s\n", hipGetErrorName(le));
}
```
